# Optimizing an MI355X kernel written in HIP

```python
import jax, jax.numpy as jnp
from jax import lax
import numpy as np

D_MODEL = 1024
BATCH = 32
SEQ = 256
DEPTH = 4
DEC_BATCH = 2
DEC_SEQ = 4096
PAST_LEN = 256

GRID_W = 64
HEAD_DIM = 64
GQA_HEADS = 6
GQA_KV_HEADS = 2
GQA_GROUP = GQA_HEADS // GQA_KV_HEADS
GQA_W = GQA_HEADS * HEAD_DIM
MLSTM_HEADS = 4
MLSTM_DK = 64
MLSTM_DV = 64
MLSTM_W = MLSTM_HEADS * MLSTM_DV
MLSTM_CHUNK = 64
MLA_HEADS = 6
MLA_Q_RANK = 256
MLA_KV_RANK = 256
MLA_NOPE = 64
MLA_ROPE = 32
MLA_V = 64
MLA_QK = MLA_NOPE + MLA_ROPE
MLA_W = MLA_HEADS * MLA_V
MIX_W = GQA_W + MLSTM_W + MLA_W
D_FF = 2816
Q_BLOCK = 128
ROPE_BASE = 10000.0
EPS = 1e-6
N_MOD = 9
IN_SPLITS = (GQA_W, GQA_KV_HEADS * HEAD_DIM, GQA_KV_HEADS * HEAD_DIM,
             MLSTM_HEADS * MLSTM_DK, MLSTM_HEADS * MLSTM_DK, MLSTM_W, MLSTM_W, 4 * MLSTM_HEADS,
             MLA_Q_RANK, MLA_KV_RANK, MLA_ROPE)
D_IN = sum(IN_SPLITS)

kernel_name = 'hybrid_gqa_mlstm_mla_dit_step'


def rms_norm(x, w):
    xf = x.astype(jnp.float32)
    y = xf * lax.rsqrt(jnp.mean(xf * xf, axis=-1, keepdims=True) + EPS)
    return (y * w).astype(x.dtype)


def swiglu(h, wg, wu, wd):
    return (jax.nn.silu(h @ wg) * (h @ wu)) @ wd


def axial_rope(rows, rot_dim):
    half = rot_dim // 2
    freqs = ROPE_BASE ** (-jnp.arange(0, half, 2, dtype=jnp.float32) / half)
    r = jnp.repeat(jnp.arange(rows, dtype=jnp.float32), GRID_W)
    c = jnp.tile(jnp.arange(GRID_W, dtype=jnp.float32), rows)
    ang = jnp.concatenate([r[:, None] * freqs, c[:, None] * freqs], axis=-1)
    return jnp.cos(ang), jnp.sin(ang)


def apply_rope(x, cos, sin):
    half = x.shape[-1] // 2
    x1, x2 = x[..., :half], x[..., half:]
    c, s = cos[None, :, None, :], sin[None, :, None, :]
    return jnp.concatenate([x1 * c - x2 * s, x1 * s + x2 * c], axis=-1).astype(x.dtype)


def block_attention(q, k, v, scale):
    B, T, KVH, G, Dq = q.shape
    nb = T // Q_BLOCK
    qb = jnp.moveaxis(q.reshape(B, nb, Q_BLOCK, KVH, G, Dq), 1, 0)

    def one_block(qblk):
        s = jnp.einsum('bqhgd,bkhd->bhgqk', qblk, k, preferred_element_type=jnp.float32) * scale
        p = jax.nn.softmax(s, axis=-1)
        return jnp.einsum('bhgqk,bkhd->bqhgd', p.astype(v.dtype), v)

    out = lax.map(one_block, qb)
    return jnp.moveaxis(out, 0, 1).reshape(B, T, KVH, G, v.shape[-1])


def mlstm_chunkwise(q, k, v, log_i, log_f, C0, n0, m0):
    B, H, T, _ = q.shape
    L = MLSTM_CHUNK
    nc = T // L

    def to_chunks(a):
        return jnp.moveaxis(a.reshape(B, H, nc, L, *a.shape[3:]), 2, 0)

    xs = tuple(to_chunks(a) for a in (q, k, v, log_i, log_f))
    causal = jnp.tril(jnp.ones((L, L), dtype=bool))

    def step(carry, inp):
        C, n, m = carry
        qc, kc, vc, li, lf = inp
        b = jnp.cumsum(lf, axis=-1)
        D = jnp.where(causal, b[..., :, None] - b[..., None, :] + li[..., None, :], -jnp.inf)
        inter = b + m[..., None]
        m_t = jnp.maximum(inter, jnp.max(D, axis=-1))
        w_inter = jnp.exp(inter - m_t)
        qk = jnp.einsum('bhtd,bhsd->bhts', qc, kc) * jnp.exp(D - m_t[..., None])
        num = w_inter[..., None] * jnp.einsum('bhtd,bhde->bhte', qc, C) + jnp.einsum('bhts,bhse->bhte', qk, vc)
        den = w_inter * jnp.einsum('bhtd,bhd->bht', qc, n) + jnp.sum(qk, axis=-1)
        h = num / jnp.maximum(jnp.abs(den), jnp.exp(-m_t))[..., None]
        bL = b[..., -1]
        decay = bL[..., None] - b + li
        m_new = jnp.maximum(bL + m, jnp.max(decay, axis=-1))
        w_old = jnp.exp(bL + m - m_new)
        w_s = jnp.exp(decay - m_new[..., None])
        C_new = w_old[..., None, None] * C + jnp.einsum('bhs,bhsd,bhse->bhde', w_s, kc, vc)
        n_new = w_old[..., None] * n + jnp.einsum('bhs,bhsd->bhd', w_s, kc)
        return (C_new, n_new, m_new), h

    (C, n, m), hs = lax.scan(step, (C0, n0, m0), xs)
    h = jnp.moveaxis(hs, 0, 2).reshape(B, H, T, v.shape[-1])
    return h, C, n, m


def maybe_flip(a, rev):
    return jnp.flip(a, axis=2) if rev else a


def mlstm_bidir(q, k, v, gates, C0, n0, m0):
    hs, Cs, ns, ms = [], [], [], []
    for d in range(2):
        rev = d == 1
        h, C, n, m = mlstm_chunkwise(
            maybe_flip(q, rev), maybe_flip(k, rev), maybe_flip(v, rev),
            maybe_flip(gates[..., 2 * d], rev),
            jax.nn.log_sigmoid(maybe_flip(gates[..., 2 * d + 1], rev)),
            C0[:, d], n0[:, d], m0[:, d])
        hs.append(maybe_flip(h, rev))
        Cs.append(C)
        ns.append(n)
        ms.append(m)
    return hs[0] + hs[1], jnp.stack(Cs, axis=1), jnp.stack(ns, axis=1), jnp.stack(ms, axis=1)


def mixer_inputs(h, lp):
    B, T, _ = h.shape
    idx = np.cumsum(IN_SPLITS)[:-1].tolist()
    gq, gk, gv, mq, mk, mv, mo, mg, qlat, kvlat, krope = jnp.split(h @ lp['w_in'], idx, axis=-1)
    gqa_q = rms_norm(gq.reshape(B, T, GQA_HEADS, HEAD_DIM), lp['gqa_q_norm'])
    gqa_k = rms_norm(gk.reshape(B, T, GQA_KV_HEADS, HEAD_DIM), lp['gqa_k_norm'])
    gqa_v = gv.reshape(B, T, GQA_KV_HEADS, HEAD_DIM)

    def heads(a, d):
        return a.reshape(B, T, MLSTM_HEADS, d).transpose(0, 2, 1, 3).astype(jnp.float32)

    ml_q = heads(mq, MLSTM_DK) * (MLSTM_DK ** -0.5)
    ml_k = heads(mk, MLSTM_DK)
    ml_v = heads(mv, MLSTM_DV)
    ml_g = (mg.reshape(B, T, 4, MLSTM_HEADS) + lp['mlstm_gate_b']).transpose(0, 3, 1, 2).astype(jnp.float32)
    mla_q = (rms_norm(qlat, lp['mla_q_norm']) @ lp['mla_w_uq']).reshape(B, T, MLA_HEADS, MLA_QK)
    mla_ckv = rms_norm(kvlat, lp['mla_kv_norm'])
    return gqa_q, gqa_k, gqa_v, ml_q, ml_k, ml_v, mo, ml_g, mla_q, mla_ckv, krope


def mla_attend(q, ckv, krope, w_ukv):
    B, S, _ = ckv.shape
    kv = (ckv @ w_ukv).reshape(B, S, MLA_HEADS, MLA_NOPE + MLA_V)
    k_nope, v = kv[..., :MLA_NOPE], kv[..., MLA_NOPE:]
    k = jnp.concatenate([k_nope, jnp.broadcast_to(krope[:, :, None, :], (B, S, MLA_HEADS, MLA_ROPE))], axis=-1)
    return block_attention(q[:, :, :, None, :], k, v, MLA_QK ** -0.5)


def mixer_output(gqa_o, ml_h, ml_o, mla_o, lp):
    B, T = gqa_o.shape[:2]
    hn = rms_norm(ml_h, lp['mlstm_out_norm'].reshape(MLSTM_HEADS, 1, MLSTM_DV))
    ml = hn.transpose(0, 2, 1, 3).reshape(B, T, MLSTM_W).astype(ml_o.dtype) * jax.nn.sigmoid(ml_o)
    cat = jnp.concatenate([gqa_o.reshape(B, T, GQA_W), ml, mla_o.reshape(B, T, MLA_W)], axis=-1)
    return cat @ lp['w_out']


def mix_context(h, lp):
    B, T, _ = h.shape
    gqa_q, gqa_k, gqa_v, ml_q, ml_k, ml_v, ml_o, ml_g, mla_q, mla_ckv, mla_kr = mixer_inputs(h, lp)
    gqa_o = block_attention(gqa_q.reshape(B, T, GQA_KV_HEADS, GQA_GROUP, HEAD_DIM), gqa_k, gqa_v, HEAD_DIM ** -0.5)
    C0 = jnp.zeros((B, 2, MLSTM_HEADS, MLSTM_DK, MLSTM_DV), jnp.float32)
    n0 = jnp.zeros((B, 2, MLSTM_HEADS, MLSTM_DK), jnp.float32)
    m0 = jnp.zeros((B, 2, MLSTM_HEADS), jnp.float32)
    ml_h, C, n, m = mlstm_bidir(ml_q, ml_k, ml_v, ml_g, C0, n0, m0)
    mla_o = mla_attend(mla_q, mla_ckv, mla_kr, lp['mla_w_ukv'])
    return mixer_output(gqa_o, ml_h, ml_o, mla_o, lp), (gqa_k, gqa_v, mla_ckv, mla_kr, C, n, m)


def mix_latent(h, lp, ctx, rope_hd, rope_mla):
    B, T, _ = h.shape
    ck, cv, cckv, ckr, C0, n0, m0 = ctx
    gqa_q, gqa_k, gqa_v, ml_q, ml_k, ml_v, ml_o, ml_g, mla_q, mla_ckv, mla_kr = mixer_inputs(h, lp)
    q = apply_rope(gqa_q, *rope_hd).reshape(B, T, GQA_KV_HEADS, GQA_GROUP, HEAD_DIM)
    k = jnp.concatenate([ck, apply_rope(gqa_k, *rope_hd)], axis=1)
    v = jnp.concatenate([cv, gqa_v], axis=1)
    gqa_o = block_attention(q, k, v, HEAD_DIM ** -0.5)
    ml_h, _, _, _ = mlstm_bidir(ml_q, ml_k, ml_v, ml_g,
                                C0.astype(jnp.float32), n0.astype(jnp.float32), m0.astype(jnp.float32))
    q_mla = jnp.concatenate([mla_q[..., :MLA_NOPE], apply_rope(mla_q[..., MLA_NOPE:], *rope_mla)], axis=-1)
    kr = apply_rope(mla_kr[:, :, None, :], *rope_mla)[:, :, 0]
    mla_o = mla_attend(q_mla, jnp.concatenate([cckv, mla_ckv], axis=1),
                       jnp.concatenate([ckr, kr], axis=1), lp['mla_w_ukv'])
    return mixer_output(gqa_o, ml_h, ml_o, mla_o, lp)


def trunk_layer(x, cond, lp, mix):
    mods = jnp.split(jax.nn.silu(cond) @ lp['w_ada'] + lp['b_ada'], N_MOD, axis=-1)
    sh1, sc1, g1, sh2, sc2, g2, sh3, sc3, g3 = [mm[:, None, :] for mm in mods]
    h = rms_norm(x, lp['norm_w'][0]) * (1 + sc1) + sh1
    x = x + 0.5 * g1 * swiglu(h, lp['ffn_w_gate'][0], lp['ffn_w_up'][0], lp['ffn_w_down'][0])
    h = rms_norm(x, lp['norm_w'][1]) * (1 + sc2) + sh2
    out, extra = mix(h)
    x = x + g2 * out
    h = rms_norm(x, lp['norm_w'][2]) * (1 + sc3) + sh3
    x = x + 0.5 * g3 * swiglu(h, lp['ffn_w_gate'][1], lp['ffn_w_up'][1], lp['ffn_w_down'][1])
    return x, extra


def setup_inputs(seed: int = 0) -> dict:
    key = jax.random.key(seed)
    ks = jax.random.split(key, 32)

    def nrm(k, shape, s=1.0):
        return s * jax.random.normal(k, shape, jnp.float32)

    return {
        'x_prompt': nrm(ks[0], (BATCH, SEQ, D_MODEL)),
        'x_sample': nrm(ks[1], (DEC_BATCH, DEC_SEQ, D_MODEL)),
        'c': nrm(ks[2], (DEC_BATCH, D_MODEL)),
        'cache_gqa_k': nrm(ks[3], (DEC_BATCH, DEPTH, PAST_LEN, GQA_KV_HEADS, HEAD_DIM)),
        'cache_gqa_v': nrm(ks[4], (DEC_BATCH, DEPTH, PAST_LEN, GQA_KV_HEADS, HEAD_DIM)),
        'cache_mla_ckv': nrm(ks[5], (DEC_BATCH, DEPTH, PAST_LEN, MLA_KV_RANK)),
        'cache_mla_krope': nrm(ks[6], (DEC_BATCH, DEPTH, PAST_LEN, MLA_ROPE)),
        'state_mlstm_C': nrm(ks[7], (DEC_BATCH, DEPTH, 2, MLSTM_HEADS, MLSTM_DK, MLSTM_DV)),
        'state_mlstm_n': nrm(ks[8], (DEC_BATCH, DEPTH, 2, MLSTM_HEADS, MLSTM_DK)),
        'state_mlstm_m': jax.random.uniform(ks[9], (DEC_BATCH, DEPTH, 2, MLSTM_HEADS), jnp.float32, 0.0, 3.0),
        'c_ctx': nrm(ks[10], (D_MODEL,)),
        'w_ada': nrm(ks[11], (DEPTH, D_MODEL, N_MOD * D_MODEL), 0.3 * D_MODEL ** -0.5),
        'b_ada': nrm(ks[12], (DEPTH, N_MOD * D_MODEL), 0.02),
        'norm_w': 1.0 + nrm(ks[13], (DEPTH, 3, D_MODEL), 0.05),
        'ffn_w_gate': nrm(ks[14], (DEPTH, 2, D_MODEL, D_FF), D_MODEL ** -0.5),
        'ffn_w_up': nrm(ks[15], (DEPTH, 2, D_MODEL, D_FF), D_MODEL ** -0.5),
        'ffn_w_down': nrm(ks[16], (DEPTH, 2, D_FF, D_MODEL), D_FF ** -0.5),
        'w_in': nrm(ks[17], (DEPTH, D_MODEL, D_IN), D_MODEL ** -0.5),
        'gqa_q_norm': 1.0 + nrm(ks[18], (DEPTH, HEAD_DIM), 0.05),
        'gqa_k_norm': 1.0 + nrm(ks[19], (DEPTH, HEAD_DIM), 0.05),
        'mlstm_gate_b': jnp.array([0.0, 3.0, 0.0, 3.0], jnp.float32)[None, :, None] + nrm(ks[20], (DEPTH, 4, MLSTM_HEADS), 0.1),
        'mlstm_out_norm': 1.0 + nrm(ks[21], (DEPTH, MLSTM_W), 0.05),
        'mla_q_norm': 1.0 + nrm(ks[22], (DEPTH, MLA_Q_RANK), 0.05),
        'mla_w_uq': nrm(ks[23], (DEPTH, MLA_Q_RANK, MLA_HEADS * MLA_QK), MLA_Q_RANK ** -0.5),
        'mla_kv_norm': 1.0 + nrm(ks[24], (DEPTH, MLA_KV_RANK), 0.05),
        'mla_w_ukv': nrm(ks[25], (DEPTH, MLA_KV_RANK, MLA_HEADS * (MLA_NOPE + MLA_V)), MLA_KV_RANK ** -0.5),
        'w_out': nrm(ks[26], (DEPTH, MIX_W, D_MODEL), MIX_W ** -0.5),
        'final_norm': 1.0 + nrm(ks[27], (D_MODEL,), 0.05),
    }


def reference(x_prompt, x_sample, c, cache_gqa_k, cache_gqa_v, cache_mla_ckv, cache_mla_krope,
              state_mlstm_C, state_mlstm_n, state_mlstm_m, c_ctx,
              w_ada, b_ada, norm_w, ffn_w_gate, ffn_w_up, ffn_w_down, w_in, gqa_q_norm, gqa_k_norm,
              mlstm_gate_b, mlstm_out_norm, mla_q_norm, mla_w_uq, mla_kv_norm, mla_w_ukv, w_out, final_norm):
    rows = x_sample.shape[1] // GRID_W
    rope_hd = axial_rope(rows, HEAD_DIM)
    rope_mla = axial_rope(rows, MLA_ROPE)
    cond_ctx = c_ctx[None, :]
    xp, xs = x_prompt, x_sample
    collected = [[] for _ in range(7)]
    for l in range(DEPTH):
        lp = {'w_ada': w_ada[l], 'b_ada': b_ada[l], 'norm_w': norm_w[l],
              'ffn_w_gate': ffn_w_gate[l], 'ffn_w_up': ffn_w_up[l], 'ffn_w_down': ffn_w_down[l],
              'w_in': w_in[l], 'gqa_q_norm': gqa_q_norm[l], 'gqa_k_norm': gqa_k_norm[l],
              'mlstm_gate_b': mlstm_gate_b[l], 'mlstm_out_norm': mlstm_out_norm[l],
              'mla_q_norm': mla_q_norm[l], 'mla_w_uq': mla_w_uq[l], 'mla_kv_norm': mla_kv_norm[l],
              'mla_w_ukv': mla_w_ukv[l], 'w_out': w_out[l]}
        xp, ctx_new = trunk_layer(xp, cond_ctx, lp, lambda h: mix_context(h, lp))
        for lst, t in zip(collected, ctx_new):
            lst.append(t)
        ctx_cached = (cache_gqa_k[:, l], cache_gqa_v[:, l], cache_mla_ckv[:, l], cache_mla_krope[:, l],
                      state_mlstm_C[:, l], state_mlstm_n[:, l], state_mlstm_m[:, l])
        xs, _ = trunk_layer(xs, c, lp, lambda h: (mix_latent(h, lp, ctx_cached, rope_hd, rope_mla), None))
    y_prompt = rms_norm(xp, final_norm)
    y_sample = rms_norm(xs, final_norm)
    new_gqa_k, new_gqa_v, new_mla_ckv, new_mla_krope, new_mlstm_C, new_mlstm_n, new_mlstm_m = [
        jnp.stack(lst, axis=1) for lst in collected]
    return (y_prompt, y_sample, new_gqa_k, new_gqa_v, new_mla_ckv, new_mla_krope, new_mlstm_C, new_mlstm_n, new_mlstm_m)
```

```cpp
#include <hip/hip_runtime.h>
#include <hip/hip_cooperative_groups.h>
#include <cstdio>
#include <cstdint>
namespace cg = cooperative_groups;

#ifndef MK_MULTI_LAUNCH
#define MK_MULTI_LAUNCH 0
#endif
namespace pg8 {
#define PG8_LAS __attribute__((address_space(3)))
__device__ __forceinline__ int lt_tid() { int t = threadIdx.x; asm volatile("" : "+v"(t)); return t; }
typedef unsigned short bf16_t;
typedef short bf16x8 __attribute__((ext_vector_type(8)));
typedef float f32x4 __attribute__((ext_vector_type(4)));
typedef unsigned u32x4 __attribute__((ext_vector_type(4)));
constexpr int BM = 256, BK = 64, HALF = 128, HTB = HALF * BK * 2  , STAGE_BYTES = 8 * HTB, NXCD = 8, WGM = 8;

__host__ __device__ __forceinline__ int lds_byte(int r, int c) { const int st = (r >> 4) * 2 + (c >> 5), rr = r & 15, cc = c & 31, ob = rr * 64 + cc * 2; return st * 1024 + (ob ^ (((ob >> 9) & 1) << 5)); }
__host__ __device__ __forceinline__ void stage_rc(int b, int& R, int& C) { const int st = b / 1024, sb = b % 1024, swz = sb ^ (((sb >> 9) & 1) << 5); R = (st >> 1) * 16 + swz / 64; C = (st & 1) * 32 + (swz % 64) / 2; }
__host__ __device__ __forceinline__ int perm32(int rho) { const int n = rho >> 4, i = rho & 15; return 8 * (i >> 2) + 4 * n + (i & 3); }

struct Unit { int pm, pn; };
struct Gemm { const bf16_t* A; const bf16_t* Bt; int M, N, K; };

struct StaticOrder {
    int nM, nN, nwg, G, c;
    __host__ __device__ void init(int M, int N, int G_, int c_) { nM = M / BM; nN = N / BM; nwg = nM * nN; G = G_; c = c_; }
    __host__ __device__ bool next(int i, Unit& u) const {
        const long L = (long)i * G + c; if (L >= nwg) return false;
        int wgid = (int)L; { const int q = nwg / NXCD, r = nwg % NXCD, xcd = wgid % NXCD, off = wgid / NXCD; wgid = (xcd < r ? xcd * (q + 1) : r * (q + 1) + (xcd - r) * q) + off; }
        const int nig = WGM * nN, gid = wgid / nig, fm = gid * WGM, gsz = (nM - fm) < WGM ? (nM - fm) : WGM;
        u.pm = fm + ((wgid % nig) % gsz); u.pn = (wgid % nig) / gsz; return true;
    }
    __device__ __forceinline__ void a_ready(const Unit&) const {}
    __device__ __forceinline__ void done(const Unit&) const {}
};

__device__ __forceinline__ unsigned cvt_pk_bf16(float lo, float hi) { unsigned r; asm volatile("v_cvt_pk_bf16_f32 %0, %1, %2" : "=v"(r) : "v"(lo), "v"(hi)); return r; }
typedef float f32x2 __attribute__((ext_vector_type(2)));
typedef unsigned u32x2 __attribute__((ext_vector_type(2)));
__device__ __forceinline__ float silu_f(float x) { return x * __builtin_amdgcn_rcpf(1.0f + __expf(-x)); }

struct EpiSwiGLU {
    static constexpr bool PERM = true, AFTER_DRAIN = false;
    bf16_t* O;
    __device__ __forceinline__ void operator()(const f32x4 (&acc)[2][2][4][2], const Unit& u, int wr, int wc, int fr, int fq) const {
        const int row0 = u.pm * BM + wr * 64 + fr, col0 = u.pn * 128 + wc * 32 + 8 * fq;
#pragma unroll
        for (int ai = 0; ai < 2; ++ai)
#pragma unroll
            for (int m = 0; m < 4; ++m) {
                bf16_t* rowp = O + (size_t)(row0 + ai * HALF + m * 16) * 2816 + col0;
                const f32x4 g0 = acc[ai][0][m][0], g1 = acc[ai][0][m][1], u0 = acc[ai][1][m][0], u1 = acc[ai][1][m][1];
                u32x4 w;
                w.x = cvt_pk_bf16(silu_f(g0[0]) * u0[0], silu_f(g0[1]) * u0[1]); w.y = cvt_pk_bf16(silu_f(g0[2]) * u0[2], silu_f(g0[3]) * u0[3]);
                w.z = cvt_pk_bf16(silu_f(g1[0]) * u1[0], silu_f(g1[1]) * u1[1]); w.w = cvt_pk_bf16(silu_f(g1[2]) * u1[2], silu_f(g1[3]) * u1[3]);
                *(u32x4*)rowp = w;
            }
    }
};
struct EpiResid {
    static constexpr bool PERM = false, AFTER_DRAIN = false;
    const float* base; float* out; const float* gmod; float gs;
    __device__ __forceinline__ void operator()(const f32x4 (&acc)[2][2][4][2], const Unit& u, int wr, int wc, int fr, int fq) const {
        const int row0 = u.pm * BM + wr * 64 + fr, col0 = u.pn * BM + wc * 32 + 4 * fq;
        const int cond = u.pm < 32 ? 0 : 1 + ((u.pm - 32) >> 4);
        const float* g = gmod + cond * 9216;
#pragma unroll
        for (int bj = 0; bj < 2; ++bj)
#pragma unroll
            for (int n = 0; n < 2; ++n) {
                const f32x4 gv = *(const f32x4*)(g + col0 + bj * HALF + n * 16) * gs;
#pragma unroll
                for (int ai = 0; ai < 2; ++ai)
#pragma unroll
                    for (int m = 0; m < 4; ++m) {
                        const size_t off = (size_t)(row0 + ai * HALF + m * 16) * 1024 + col0 + bj * HALF + n * 16;
                        *(f32x4*)(out + off) = *(const f32x4*)(base + off) + gv * acc[ai][bj][m][n];
                    }
            }
    }
};
struct EpiF32 {
    static constexpr bool PERM = false, AFTER_DRAIN = false;
    float* out; int ldc;
    __device__ __forceinline__ void operator()(const f32x4 (&acc)[2][2][4][2], const Unit& u, int wr, int wc, int fr, int fq) const {
        const int row0 = u.pm * BM + wr * 64 + fr, col0 = u.pn * BM + wc * 32 + 4 * fq;
#pragma unroll
        for (int ai = 0; ai < 2; ++ai)
#pragma unroll
            for (int m = 0; m < 4; ++m)
#pragma unroll
                for (int bj = 0; bj < 2; ++bj)
#pragma unroll
                    for (int n = 0; n < 2; ++n)
                        *(f32x4*)(out + (size_t)(row0 + ai * HALF + m * 16) * ldc + col0 + bj * HALF + n * 16) = acc[ai][bj][m][n];
    }
};
struct EpiBf16S {
    static constexpr bool PERM = true, AFTER_DRAIN = false;
    bf16_t* O; int ldc; float scale;
    __device__ __forceinline__ void operator()(const f32x4 (&acc)[2][2][4][2], const Unit& u, int wr, int wc, int fr, int fq) const {
        const int row0 = u.pm * BM + wr * 64 + fr, col0 = u.pn * BM + wc * 32 + 8 * fq;
#pragma unroll
        for (int ai = 0; ai < 2; ++ai)
#pragma unroll
            for (int m = 0; m < 4; ++m) {
                bf16_t* rowp = O + (size_t)(row0 + ai * HALF + m * 16) * ldc + col0;
#pragma unroll
                for (int bj = 0; bj < 2; ++bj) {
                    const f32x4 v0 = acc[ai][bj][m][0] * scale, v1 = acc[ai][bj][m][1] * scale;
                    u32x4 w; w.x = cvt_pk_bf16(v0[0], v0[1]); w.y = cvt_pk_bf16(v0[2], v0[3]); w.z = cvt_pk_bf16(v1[0], v1[1]); w.w = cvt_pk_bf16(v1[2], v1[3]);
                    *(u32x4*)(rowp + bj * HALF) = w;
                }
            }
    }
};
template <class Epi, class Sched, bool ALIGN_EPI = false, bool SP2 = false>
__device__ __forceinline__ void gemm_phase(PG8_LAS unsigned char* lds, const Gemm g, const Sched& S, const Epi& E) {
    const int tid = lt_tid(), wid = __builtin_amdgcn_readfirstlane(tid >> 6), lane = tid & 63, wr = wid >> 2, wc = wid & 3, fr = lane & 15, fq = lane >> 4;
    const int K = g.K, nt = K / BK;
    unsigned voffA[2], voffB[2];
#pragma unroll
    for (int i = 0; i < 2; ++i) { int R, C; stage_rc(tid * 16 + i * 8192, R, C); const int Rb = Epi::PERM ? ((R & ~31) + perm32(R & 31)) : R;
        voffA[i] = (unsigned)(R * K + C) * 2u; voffB[i] = (unsigned)(Rb * K + C) * 2u; }
    const size_t kstep = (size_t)(BK * 2);
    const size_t hstep = (size_t)HALF * K * 2;
    const size_t tstep = 2 * hstep;
    const unsigned ldsw = (unsigned)wid * 1024u;
    const int aoff = lds_byte(wr * 64 + fr, fq * 8), boff = lds_byte(wc * 32 + fr, fq * 8);
#define PG8_SA(b, h) (((b) * 2 + (h)) * HTB)
#define PG8_SB(b, h) ((4 + (b) * 2 + (h)) * HTB)
#define PG8_STAGE(bufoff, gbase, voff) do { _Pragma("unroll") for (int _i = 0; _i < 2; ++_i) \
        __builtin_amdgcn_global_load_lds((const unsigned*)((const char*)(gbase) + (voff)[_i]), (PG8_LAS unsigned*)(lds + (bufoff) + ldsw + _i * 8192), 16, 0, 0); } while (0)
#define PG8_LDA(dst, b, h) do { _Pragma("unroll") for (int m = 0; m < 4; ++m) _Pragma("unroll") for (int k = 0; k < 2; ++k) dst[m][k] = *(const PG8_LAS bf16x8*)(lds + PG8_SA(b, h) + aoff + m * 2048 + k * 1024); } while (0)
#define PG8_LDB(dst, b, h) do { _Pragma("unroll") for (int n = 0; n < 2; ++n) _Pragma("unroll") for (int k = 0; k < 2; ++k) dst[n][k] = *(const PG8_LAS bf16x8*)(lds + PG8_SB(b, h) + boff + n * 2048 + k * 1024); } while (0)
#define PG8_MMA(ai, bj, At, Bt) do { __builtin_amdgcn_s_setprio(1); _Pragma("unroll") for (int m = 0; m < 4; ++m) _Pragma("unroll") for (int n = 0; n < 2; ++n) _Pragma("unroll") for (int k = 0; k < 2; ++k) \
        acc[ai][bj][m][n] = __builtin_amdgcn_mfma_f32_16x16x32_bf16(Bt[n][k], At[m][k], acc[ai][bj][m][n], 0, 0, 0); __builtin_amdgcn_s_setprio(0); } while (0)
#define PG8_WAIT_V(n) asm volatile("s_waitcnt vmcnt(" #n ")" ::: "memory")
#define PG8_WAIT_L(n) asm volatile("s_waitcnt lgkmcnt(" #n ")" ::: "memory")
#define PG8_BAR __builtin_amdgcn_s_barrier()
#define PG8_SCHED __builtin_amdgcn_sched_barrier(0)
    Unit cur, nxt; int ui = 0;
    if (!S.next(0, cur)) return;
    f32x4 acc[2][2][4][2];
#pragma unroll
    for (int a = 0; a < 2; ++a)
#pragma unroll
        for (int b = 0; b < 2; ++b)
#pragma unroll
            for (int m = 0; m < 4; ++m)
#pragma unroll
                for (int n = 0; n < 2; ++n) acc[a][b][m][n] = (f32x4){0.f, 0.f, 0.f, 0.f};
    bf16x8 At[4][2], B0[2][2], B1[2][2];
    const char* cA = (const char*)g.A + (size_t)cur.pm * tstep; const char* cB = (const char*)g.Bt + (size_t)cur.pn * tstep;
    S.a_ready(cur);
    if constexpr (SP2) {
        PG8_STAGE(PG8_SB(0, 0), cB, voffB); PG8_STAGE(PG8_SB(0, 1), cB + hstep, voffB); PG8_STAGE(PG8_SA(0, 0), cA, voffA); PG8_STAGE(PG8_SA(0, 1), cA + hstep, voffA);
        if (wr == 1) PG8_BAR;
        PG8_WAIT_V(2); PG8_BAR;
        PG8_STAGE(PG8_SB(1, 0), cB + kstep, voffB); PG8_STAGE(PG8_SA(1, 0), cA + kstep, voffA); PG8_STAGE(PG8_SB(1, 1), cB + hstep + kstep, voffB);
        PG8_WAIT_V(6); PG8_BAR;
    } else {
        PG8_STAGE(PG8_SB(0, 0), cB, voffB); PG8_STAGE(PG8_SA(0, 0), cA, voffA); PG8_STAGE(PG8_SB(0, 1), cB + hstep, voffB); PG8_STAGE(PG8_SA(0, 1), cA + hstep, voffA);
        if (wr == 1) PG8_BAR;
        PG8_WAIT_V(4); PG8_BAR;
        PG8_STAGE(PG8_SB(1, 0), cB + kstep, voffB); PG8_STAGE(PG8_SA(1, 0), cA + kstep, voffA); PG8_STAGE(PG8_SB(1, 1), cB + hstep + kstep, voffB);
        PG8_WAIT_V(6); PG8_BAR;
    }
    for (;;) {
        const bool has_next = S.next(ui + 1, nxt);
        const char* nA = has_next ? (const char*)g.A + (size_t)nxt.pm * tstep : cA; const char* nB = has_next ? (const char*)g.Bt + (size_t)nxt.pn * tstep : cB;
        for (int t = 0; t < nt; t += 2) {
            const bool last = (t == nt - 2);
            const char* a1 = cA + (size_t)(t + 1) * kstep;
            const char* a2 = last ? nA : cA + (size_t)(t + 2) * kstep; const char* b2 = last ? nB : cB + (size_t)(t + 2) * kstep;
            const char* a3 = a2 + kstep; const char* b3 = b2 + kstep;
            if (last && has_next) S.a_ready(nxt);
            if constexpr (SP2) {
            PG8_LDB(B0, 0, 0); PG8_LDB(B1, 0, 1); PG8_SCHED; PG8_LDA(At, 0, 0); PG8_STAGE(PG8_SA(1, 1), a1 + hstep, voffA);
            PG8_WAIT_V(8); PG8_WAIT_L(0); PG8_BAR; PG8_MMA(0, 0, At, B0); PG8_MMA(0, 1, At, B1); PG8_BAR; PG8_SCHED;
            PG8_LDA(At, 0, 1); PG8_STAGE(PG8_SB(0, 0), b2, voffB); PG8_STAGE(PG8_SB(0, 1), b2 + hstep, voffB); PG8_STAGE(PG8_SA(0, 0), a2, voffA);
            PG8_WAIT_V(8); PG8_WAIT_L(0); PG8_BAR; PG8_MMA(1, 0, At, B0); PG8_MMA(1, 1, At, B1); PG8_BAR; PG8_SCHED;
            PG8_LDB(B0, 1, 0); PG8_LDB(B1, 1, 1); PG8_SCHED; PG8_LDA(At, 1, 0); PG8_STAGE(PG8_SA(0, 1), a2 + hstep, voffA);
            PG8_WAIT_V(8); PG8_WAIT_L(0); PG8_BAR; PG8_MMA(0, 0, At, B0); PG8_MMA(0, 1, At, B1); PG8_BAR; PG8_SCHED;
            PG8_LDA(At, 1, 1); PG8_STAGE(PG8_SB(1, 0), b3, voffB); PG8_STAGE(PG8_SB(1, 1), b3 + hstep, voffB); PG8_STAGE(PG8_SA(1, 0), a3, voffA);
            PG8_WAIT_V(8); PG8_WAIT_L(0); PG8_BAR; PG8_MMA(1, 0, At, B0); PG8_MMA(1, 1, At, B1); PG8_BAR; PG8_SCHED;
            } else {
            PG8_LDB(B0, 0, 0); PG8_SCHED; PG8_LDA(At, 0, 0); PG8_STAGE(PG8_SA(1, 1), a1 + hstep, voffA);
            PG8_WAIT_L(8); PG8_BAR; PG8_WAIT_L(0); PG8_MMA(0, 0, At, B0); PG8_BAR; PG8_SCHED;
            PG8_LDB(B1, 0, 1); PG8_STAGE(PG8_SB(0, 0), b2, voffB);
            PG8_BAR; PG8_WAIT_L(0); PG8_MMA(0, 1, At, B1); PG8_BAR;
            PG8_LDA(At, 0, 1); PG8_STAGE(PG8_SA(0, 0), a2, voffA);
            PG8_BAR; PG8_WAIT_L(0); PG8_MMA(1, 0, At, B0); PG8_BAR; PG8_SCHED;
            PG8_STAGE(PG8_SB(0, 1), b2 + hstep, voffB);
            PG8_WAIT_V(6); PG8_BAR; PG8_MMA(1, 1, At, B1); PG8_BAR;
            PG8_LDB(B0, 1, 0); PG8_SCHED; PG8_LDA(At, 1, 0); PG8_STAGE(PG8_SA(0, 1), a2 + hstep, voffA);
            PG8_WAIT_L(8); PG8_BAR; PG8_WAIT_L(0); PG8_MMA(0, 0, At, B0); PG8_BAR; PG8_SCHED;
            PG8_LDB(B1, 1, 1); PG8_STAGE(PG8_SB(1, 0), b3, voffB);
            PG8_BAR; PG8_WAIT_L(0); PG8_MMA(0, 1, At, B1); PG8_BAR;
            PG8_LDA(At, 1, 1); PG8_STAGE(PG8_SA(1, 0), a3, voffA);
            PG8_BAR; PG8_WAIT_L(0); PG8_MMA(1, 0, At, B0); PG8_BAR; PG8_SCHED;
            PG8_STAGE(PG8_SB(1, 1), b3 + hstep, voffB);
            PG8_WAIT_V(6); PG8_BAR; PG8_MMA(1, 1, At, B1); PG8_BAR;
            }
        }
        if constexpr (ALIGN_EPI) { if (wr == 0) PG8_BAR; }
        if constexpr (!Epi::AFTER_DRAIN) { E(acc, cur, wr, wc, fr, fq); S.done(cur); }
        if (!has_next) break;
#pragma unroll
        for (int a = 0; a < 2; ++a)
#pragma unroll
            for (int b = 0; b < 2; ++b)
#pragma unroll
                for (int m = 0; m < 4; ++m)
#pragma unroll
                    for (int n = 0; n < 2; ++n) acc[a][b][m][n] = (f32x4){0.f, 0.f, 0.f, 0.f};
        cur = nxt; cA = nA; cB = nB; ++ui;
        if constexpr (ALIGN_EPI) { if (wr == 1) PG8_BAR; }
    }
    PG8_WAIT_V(0);
    if constexpr (!ALIGN_EPI) { if (wr == 0) PG8_BAR; }
    PG8_BAR;
    if constexpr (Epi::AFTER_DRAIN) { E.fused(acc, cur, wr, wc, fr, fq, lds, wid, lane); S.done(cur); }
#undef PG8_SA
#undef PG8_SB
#undef PG8_STAGE
#undef PG8_LDA
#undef PG8_LDB
#undef PG8_MMA
#undef PG8_WAIT_V
#undef PG8_WAIT_L
#undef PG8_BAR
#undef PG8_SCHED
}
}
#define LAS __attribute__((address_space(3)))
typedef unsigned short bf16_t;
typedef short bf16x8 __attribute__((ext_vector_type(8)));
typedef short s16x4 __attribute__((ext_vector_type(4)));
typedef float f32x4 __attribute__((ext_vector_type(4)));
typedef float f32x16 __attribute__((ext_vector_type(16)));
typedef unsigned u32x4 __attribute__((ext_vector_type(4)));
typedef unsigned u32x2 __attribute__((ext_vector_type(2)));
using pg8::cvt_pk_bf16;

#ifndef MK_PHM
#define MK_PHM 0xFFFF
#endif
constexpr int PHM = MK_PHM;
constexpr int NTHREADS = 512, NWAVES = 8;
constexpr int M = 16384, MCTX = 8192, DM = 1024, FF = 2816, NGU = 2 * FF, DIN = 2224, NIN = 2304, KVROWS = 16896, NLAYER = 4;
constexpr float EPS = 1e-6f, LOG2E = 1.4426950408889634f;
constexpr int LDS_BYTES = 131072 + 1024;

constexpr size_t al256(size_t x) { return (x + 255) & ~(size_t)255; }
constexpr size_t SZ_WGU1 = (size_t)NGU * DM * 2, SZ_WD1 = (size_t)DM * FF * 2, SZ_WIN1 = (size_t)NIN * DM * 2, SZ_WOUT1 = (size_t)DM * DM * 2, SZ_WUQ1 = (size_t)768 * 256 * 2, SZ_WUKV1 = (size_t)768 * 256 * 2;
constexpr size_t WS_WGU = 0;
constexpr size_t WS_WD = WS_WGU + 8 * SZ_WGU1;
constexpr size_t WS_WIN = WS_WD + 8 * SZ_WD1;
constexpr size_t WS_WOUT = WS_WIN + 4 * SZ_WIN1;
constexpr size_t WS_WUQ = WS_WOUT + 4 * SZ_WOUT1;
constexpr size_t WS_WUKV = WS_WUQ + 4 * SZ_WUQ1;
constexpr size_t WS_MODS = WS_WUKV + 4 * SZ_WUKV1;
constexpr size_t WS_ROPE64 = WS_MODS + al256((size_t)4 * 3 * 9216 * 4);
constexpr size_t WS_ROPE32 = WS_ROPE64 + (size_t)4096 * 64 * 4;
constexpr size_t WS_X = WS_ROPE32 + (size_t)4096 * 32 * 4;
constexpr size_t WS_XN = WS_X + (size_t)M * DM * 4;
constexpr size_t WS_R1 = WS_XN + (size_t)M * DM * 2;
constexpr size_t SZ_R1 = (size_t)M * FF * 2;
constexpr size_t WS_PROJ = WS_R1 + SZ_R1;
constexpr size_t WS_MLA = WS_PROJ + (size_t)M * NIN * 4;
constexpr size_t WS_MLN = WS_MLA + (size_t)2048 * 4096 * 4;
constexpr size_t WS_MLS = WS_MLN + (size_t)2048 * 64 * 4;
constexpr size_t WS_END = WS_MLS + (size_t)2048 * 4 * 4;
constexpr size_t R1_QG = 0;
constexpr size_t R1_KG = R1_QG + (size_t)M * 384 * 2;
constexpr size_t R1_VG = R1_KG + (size_t)KVROWS * 128 * 2;
constexpr size_t R1_QLATN = R1_VG + (size_t)KVROWS * 128 * 2;
constexpr size_t R1_CKV = R1_QLATN + (size_t)M * 256 * 2;
constexpr size_t R1_KROPE = R1_CKV + (size_t)KVROWS * 256 * 2;
constexpr size_t R1_QM = R1_KROPE + (size_t)KVROWS * 32 * 2;
constexpr size_t R1_KVM = R1_QM + (size_t)M * 768 * 2;
constexpr size_t R1_END = R1_KVM + (size_t)KVROWS * 768 * 2;
static_assert(R1_END <= SZ_R1, "mixer overlay fits in the ACT region");
static_assert(R1_KG % 256 == 0 && R1_VG % 256 == 0 && R1_QLATN % 256 == 0 && R1_CKV % 256 == 0 && R1_KROPE % 256 == 0 && R1_QM % 256 == 0 && R1_KVM % 256 == 0, "alignment");
static_assert(WS_MODS % 256 == 0 && WS_X % 256 == 0 && WS_R1 % 256 == 0 && WS_PROJ % 256 == 0, "alignment");

constexpr size_t O_YP = 0, O_YS = 8388608, O_GK = 16777216, O_GV = 20971520, O_CKV = 25165824, O_KR = 33554432, O_C = 34603008, O_N = 38797312, O_MM = 38862848;
constexpr int C_GQ = 0, C_GK = 384, C_GV = 512, C_MQ = 640, C_MK = 896, C_MV = 1152, C_MO = 1408, C_MG = 1664, C_QLAT = 1680, C_KVLAT = 1936, C_KROPE = 2192;

struct Args { const float* in[28]; float* out; unsigned char* ws; int ph_lo, ph_hi; };
typedef const __attribute__((address_space(4))) Args* ArgsP;

__device__ __forceinline__ float wave_sum(float v) {
#pragma unroll
    for (int o = 1; o < 64; o <<= 1) v += __shfl_xor(v, o);
    return v;
}
__device__ __forceinline__ float wave_max(float v) {
#pragma unroll
    for (int o = 1; o < 64; o <<= 1) v = fmaxf(v, __shfl_xor(v, o));
    return v;
}
__device__ __forceinline__ unsigned short bf1(float v) { return (unsigned short)(cvt_pk_bf16(v, 0.f) & 0xffffu); }
__device__ __forceinline__ int crow(int r, int hi) { return (r & 3) + 8 * (r >> 2) + 4 * hi; }
__device__ __forceinline__ float log_sigmoid(float x) { return fminf(x, 0.f) - log1pf(__expf(-fabsf(x))); }
__device__ __forceinline__ float scan_sum(float v, int lane) {
#pragma unroll
    for (int o = 1; o < 64; o <<= 1) { const float t = __shfl_up(v, o); if (lane >= o) v += t; }
    return v;
}
__device__ __forceinline__ float scan_max(float v, int lane) {
#pragma unroll
    for (int o = 1; o < 64; o <<= 1) { const float t = __shfl_up(v, o); if (lane >= o) v = fmaxf(v, t); }
    return v;
}

__device__ __forceinline__ void transpose_item(const float* W, int K, int N, bf16_t* WT, int dst_row0, int k0, int n0, LAS float* scr, int lane) {
    const int nn = n0 + (lane & 31);
#pragma unroll 8
    for (int i = 0; i < 32; ++i) { const int kk = 2 * i + (lane >> 5); scr[kk * 33 + (lane & 31)] = (nn < N) ? W[(size_t)(k0 + kk) * N + nn] : 0.f; }
    asm volatile("s_waitcnt lgkmcnt(0)" ::: "memory");
    const int c = lane & 7;
#pragma unroll
    for (int j = 0; j < 4; ++j) {
        const int n = (lane >> 3) + 8 * j; const LAS float* s = scr + (8 * c) * 33 + n;
        u32x4 o; o.x = cvt_pk_bf16(s[0 * 33], s[1 * 33]); o.y = cvt_pk_bf16(s[2 * 33], s[3 * 33]); o.z = cvt_pk_bf16(s[4 * 33], s[5 * 33]); o.w = cvt_pk_bf16(s[6 * 33], s[7 * 33]);
        *(u32x4*)(WT + (size_t)(dst_row0 + n) * K + k0 + 8 * c) = o;
    }
    asm volatile("s_waitcnt lgkmcnt(0)" ::: "memory");
}
__device__ __forceinline__ void sincos_f(float x, float& s, float& c) {
    const float k = __builtin_rintf(x * 0.63661977236758134308f);
    float r = __builtin_fmaf(-k, 1.5703125f, x); r = __builtin_fmaf(-k, 4.837512969970703125e-4f, r); r = __builtin_fmaf(-k, 7.54978995489188e-8f, r);
    const float r2 = r * r;
    float sp = 2.7557319e-6f; sp = sp * r2 - 1.9841270e-4f; sp = sp * r2 + 8.3333333e-3f; sp = sp * r2 - 1.6666667e-1f; sp = sp * r2 * r + r;
    float cp = 2.4801587e-5f; cp = cp * r2 - 1.3888889e-3f; cp = cp * r2 + 4.1666667e-2f; cp = cp * r2 - 0.5f; cp = cp * r2 + 1.0f;
    const int q = ((int)k) & 3;
    s = (q == 0) ? sp : (q == 1) ? cp : (q == 2) ? -sp : -cp;
    c = (q == 0) ? cp : (q == 1) ? -sp : (q == 2) ? -cp : sp;
}
__device__ __forceinline__ float rope_freq16(int fi) {
    const int a = fi & 3, b = fi >> 2;
    const float f = (a == 0) ? 1.0f : (a == 1) ? 0.56234132519034908f : (a == 2) ? 0.31622776601683794f : 0.17782794100389228f;
    const float g = (b == 0) ? 1.0f : (b == 1) ? 0.1f : (b == 2) ? 0.01f : 0.001f;
    return f * g;
}
struct TDesc { int in_idx, K, N, nb, mode, items; unsigned long long ws_off, dst_bytes; };
__device__ const TDesc TD[7] = {
    {14, 1024, 2816, 88, 1, 8 * 16 * 88, WS_WGU, SZ_WGU1},
    {15, 1024, 2816, 88, 2, 8 * 16 * 88, WS_WGU, SZ_WGU1},
    {16, 2816, 1024, 32, 0, 8 * 44 * 32, WS_WD, SZ_WD1},
    {17, 1024, 2224, 72, 0, 4 * 16 * 72, WS_WIN, SZ_WIN1},
    {26, 1024, 1024, 32, 0, 4 * 16 * 32, WS_WOUT, SZ_WOUT1},
    {23, 256, 576, 24, 0, 4 * 4 * 24, WS_WUQ, SZ_WUQ1},
    {25, 256, 768, 24, 0, 4 * 4 * 24, WS_WUKV, SZ_WUKV1}};
__device__ __forceinline__ void phase_prologue(ArgsP a, LAS unsigned char* lds) {
    const int tid = pg8::lt_tid(), lane = tid & 63, wave = tid >> 6;
    const int G = gridDim.x, gw = blockIdx.x * NWAVES + wave, NGW = G * NWAVES;
    unsigned char* ws = a->ws;
    {
        LAS float* scr = (LAS float*)(lds + wave * 8704);
        int total = 0;
#pragma unroll 1
        for (int d = 0; d < 7; ++d) total += TD[d].items;
#pragma unroll 1
        for (int it = gw; it < total; it += NGW) {
            int d = 0, r = it;
#pragma unroll 1
            while (r >= TD[d].items) { r -= TD[d].items; ++d; }
            const int K = TD[d].K, N = TD[d].N, nb = TD[d].nb, mode = TD[d].mode, per_mat = (K >> 6) * nb;
            const int m = r / per_mat, sub = r % per_mat, kb = sub / nb, n0 = (sub % nb) * 32;
            const float* W = a->in[TD[d].in_idx] + (size_t)m * K * N;
            bf16_t* WT = (bf16_t*)(ws + TD[d].ws_off + (size_t)m * TD[d].dst_bytes);
            const int drow = mode == 0 ? n0 : (n0 >> 7) * 256 + (mode == 2 ? 128 : 0) + (n0 & 127);
            transpose_item(W, K, N, WT, drow, kb * 64, n0, scr, lane);
        }
    }
    __syncthreads();
    {
        LAS float* sc = (LAS float*)lds;
        LAS float* red = (LAS float*)(lds + 12288);
        for (int i = tid; i < 3072; i += NTHREADS) { const int cd = i >> 10, k = i & 1023; const float v = (cd == 0) ? a->in[10][k] : a->in[2][(cd - 1) * 1024 + k]; sc[i] = v / (1.0f + __expf(-v)); }
        __syncthreads();
        float* mods = (float*)(ws + WS_MODS);
        const int kp = tid >> 6, ci = tid & 63;
        for (int it = blockIdx.x; it < NLAYER * 144; it += G) {
            const int l = it / 144, n0 = (it % 144) * 64;
            const float* W = a->in[11] + (size_t)l * DM * 9216 + n0 + ci;
            float a0 = 0.f, a1 = 0.f, a2 = 0.f;
#pragma unroll 8
            for (int k = kp * 128; k < kp * 128 + 128; ++k) { const float w = W[(size_t)k * 9216]; a0 += sc[k] * w; a1 += sc[1024 + k] * w; a2 += sc[2048 + k] * w; }
            red[(kp * 3 + 0) * 64 + ci] = a0; red[(kp * 3 + 1) * 64 + ci] = a1; red[(kp * 3 + 2) * 64 + ci] = a2;
            __syncthreads();
            if (tid < 192) { const int cd = tid >> 6; float s = a->in[12][(size_t)l * 9216 + n0 + ci];
#pragma unroll
                for (int q = 0; q < 8; ++q) s += red[(q * 3 + cd) * 64 + ci];
                mods[((size_t)l * 3 + cd) * 9216 + n0 + ci] = s; }
            __syncthreads();
        }
    }
    {
        f32x4* X = (f32x4*)(ws + WS_X);
        const f32x4* xp = (const f32x4*)a->in[0]; const f32x4* xs = (const f32x4*)a->in[1];
        const size_t half = (size_t)MCTX * DM / 4;
        for (size_t i = (size_t)blockIdx.x * NTHREADS + tid; i < half; i += (size_t)G * NTHREADS) { X[i] = xp[i]; X[half + i] = xs[i]; }
    }
    {
        float* r64 = (float*)(ws + WS_ROPE64); float* r32 = (float*)(ws + WS_ROPE32);
        for (int i = blockIdx.x * NTHREADS + tid; i < 4096 * 32 + 4096 * 16; i += G * NTHREADS) {
            if (i < 4096 * 32) { const int t = i >> 5, j = i & 31; const int pos = (j < 16) ? (t >> 6) : (t & 63); const float ang = (float)pos * rope_freq16(j & 15);
                float s, c; sincos_f(ang, s, c); r64[(size_t)t * 64 + j] = c; r64[(size_t)t * 64 + 32 + j] = s; }
            else { const int ii = i - 4096 * 32; const int t = ii >> 4, j = ii & 15; const int pos = (j < 8) ? (t >> 6) : (t & 63); const float ang = (float)pos * rope_freq16(2 * (j & 7));
                float s, c; sincos_f(ang, s, c); r32[(size_t)t * 32 + j] = c; r32[(size_t)t * 32 + 16 + j] = s; }
        }
    }
}

__device__ __forceinline__ void phase_norm(ArgsP a, int l, int which) {
    const int tid = pg8::lt_tid(), lane = tid & 63, wave = tid >> 6;
    const int gw = blockIdx.x * NWAVES + wave, NGW = gridDim.x * NWAVES;
    const float* X = (const float*)(a->ws + WS_X); bf16_t* XN = (bf16_t*)(a->ws + WS_XN);
    const float* nw = a->in[13] + (size_t)(l * 3 + which) * 1024;
    const float* mods = (const float*)(a->ws + WS_MODS) + (size_t)l * 3 * 9216;
    for (int row = gw; row < M; row += NGW) {
        const int cond = row < MCTX ? 0 : 1 + ((row - MCTX) >> 12);
        const float* sh = mods + cond * 9216 + (3 * which) * 1024; const float* sc = sh + 1024;
        const f32x4* xr = (const f32x4*)(X + (size_t)row * DM) + lane;
        f32x4 v[4]; float s = 0.f;
#pragma unroll
        for (int j = 0; j < 4; ++j) { v[j] = xr[64 * j]; s += (v[j].x * v[j].x + v[j].y * v[j].y) + (v[j].z * v[j].z + v[j].w * v[j].w); }
        const float rstd = 1.0f / sqrtf(wave_sum(s) * (1.0f / DM) + EPS);
        u32x2* o = (u32x2*)(XN + (size_t)row * DM) + lane;
#pragma unroll
        for (int j = 0; j < 4; ++j) {
            const int col = 4 * lane + 256 * j;
            const f32x4 w = *(const f32x4*)(nw + col), cs = *(const f32x4*)(sc + col), hs = *(const f32x4*)(sh + col);
            const f32x4 h = v[j] * rstd * w * (cs + 1.0f) + hs;
            u32x2 p; p.x = cvt_pk_bf16(h.x, h.y); p.y = cvt_pk_bf16(h.z, h.w); o[64 * j] = p;
        }
    }
}
__device__ __forceinline__ void phase_final_norm(ArgsP a) {
    const int tid = pg8::lt_tid(), lane = tid & 63, wave = tid >> 6;
    const int gw = blockIdx.x * NWAVES + wave, NGW = gridDim.x * NWAVES;
    const float* X = (const float*)(a->ws + WS_X); const float* nw = a->in[27];
    for (int row = gw; row < M; row += NGW) {
        const f32x4* xr = (const f32x4*)(X + (size_t)row * DM) + lane;
        f32x4 v[4]; float s = 0.f;
#pragma unroll
        for (int j = 0; j < 4; ++j) { v[j] = xr[64 * j]; s += (v[j].x * v[j].x + v[j].y * v[j].y) + (v[j].z * v[j].z + v[j].w * v[j].w); }
        const float rstd = 1.0f / sqrtf(wave_sum(s) * (1.0f / DM) + EPS);
        f32x4* o = (f32x4*)(a->out + (size_t)row * DM) + lane;
#pragma unroll
        for (int j = 0; j < 4; ++j) o[64 * j] = v[j] * rstd * *(const f32x4*)(nw + 4 * lane + 256 * j);
    }
}

__device__ __forceinline__ void phase_prep(ArgsP a, int l) {
    const int tid = pg8::lt_tid(), lane = tid & 63, wave = tid >> 6;
    const int gw = blockIdx.x * NWAVES + wave, NGW = gridDim.x * NWAVES;
    unsigned char* r1 = a->ws + WS_R1;
    bf16_t* QG = (bf16_t*)(r1 + R1_QG); bf16_t* KG = (bf16_t*)(r1 + R1_KG); bf16_t* VG = (bf16_t*)(r1 + R1_VG);
    bf16_t* QLATN = (bf16_t*)(r1 + R1_QLATN); bf16_t* CKV = (bf16_t*)(r1 + R1_CKV); bf16_t* KROPE = (bf16_t*)(r1 + R1_KROPE);
    const float* PROJ = (const float*)(a->ws + WS_PROJ);
    const float* R64 = (const float*)(a->ws + WS_ROPE64); const float* R32 = (const float*)(a->ws + WS_ROPE32);
    const float* qn = a->in[18] + l * 64; const float* kn = a->in[19] + l * 64;
    const float* mqn = a->in[22] + l * 256; const float* mkvn = a->in[24] + l * 256;
    const float qscale = 0.125f * LOG2E;
    for (int it = gw; it < M + 512; it += NGW) {
        if (it < M) {
            const int row = it; const bool lat = row >= MCTX;
            const int b = lat ? (row - MCTX) >> 12 : row >> 8, t = lat ? (row - MCTX) & 4095 : row & 255;
            const int kvrow = lat ? MCTX + b * 4352 + 256 + t : row;
            const float* pr = PROJ + (size_t)row * NIN;
            const size_t octx = ((size_t)(b * 4 + l) * 256 + t);
            float c64 = 0.f, s64 = 0.f;
            if (lat) { c64 = R64[(size_t)t * 64 + (lane & 31)]; s64 = R64[(size_t)t * 64 + 32 + (lane & 31)]; }
            const float qnw = qn[lane], knw = kn[lane];
#pragma unroll
            for (int h = 0; h < 6; ++h) {
                const float v = pr[C_GQ + 64 * h + lane];
                float y = v * (1.0f / sqrtf(wave_sum(v * v) * (1.0f / 64.0f) + EPS)) * qnw;
                if (lat) { const float p = __shfl_xor(y, 32); y = (lane < 32) ? (y * c64 - p * s64) : (p * s64 + y * c64); }
                QG[(size_t)row * 384 + 64 * h + lane] = bf1(y * qscale);
            }
#pragma unroll
            for (int kvh = 0; kvh < 2; ++kvh) {
                const float v = pr[C_GK + 64 * kvh + lane];
                float y = v * (1.0f / sqrtf(wave_sum(v * v) * (1.0f / 64.0f) + EPS)) * knw;
                if (!lat) a->out[O_GK + octx * 128 + 64 * kvh + lane] = y;
                else { const float p = __shfl_xor(y, 32); y = (lane < 32) ? (y * c64 - p * s64) : (p * s64 + y * c64); }
                KG[(size_t)kvrow * 128 + 64 * kvh + lane] = bf1(y);
                const float vv = pr[C_GV + 64 * kvh + lane];
                if (!lat) a->out[O_GV + octx * 128 + 64 * kvh + lane] = vv;
                VG[(size_t)kvrow * 128 + 64 * kvh + lane] = bf1(vv);
            }
            {
                const f32x4 v = *(const f32x4*)(pr + C_QLAT + 4 * lane);
                const float rstd = 1.0f / sqrtf(wave_sum((v.x * v.x + v.y * v.y) + (v.z * v.z + v.w * v.w)) * (1.0f / 256.0f) + EPS);
                const f32x4 y = v * rstd * *(const f32x4*)(mqn + 4 * lane);
                u32x2 p; p.x = cvt_pk_bf16(y.x, y.y); p.y = cvt_pk_bf16(y.z, y.w); *(u32x2*)(QLATN + (size_t)row * 256 + 4 * lane) = p;
            }
            {
                const f32x4 v = *(const f32x4*)(pr + C_KVLAT + 4 * lane);
                const float rstd = 1.0f / sqrtf(wave_sum((v.x * v.x + v.y * v.y) + (v.z * v.z + v.w * v.w)) * (1.0f / 256.0f) + EPS);
                const f32x4 y = v * rstd * *(const f32x4*)(mkvn + 4 * lane);
                if (!lat) *(f32x4*)(a->out + O_CKV + octx * 256 + 4 * lane) = y;
                u32x2 p; p.x = cvt_pk_bf16(y.x, y.y); p.y = cvt_pk_bf16(y.z, y.w); *(u32x2*)(CKV + (size_t)kvrow * 256 + 4 * lane) = p;
            }
            {
                float v = pr[C_KROPE + (lane & 31)];
                if (!lat) { if (lane < 32) a->out[O_KR + octx * 32 + lane] = v; }
                else { const float c = R32[(size_t)t * 32 + (lane & 15)], s = R32[(size_t)t * 32 + 16 + (lane & 15)]; const float p = __shfl_xor(v, 16); v = (lane & 16) ? (p * s + v * c) : (v * c - p * s); }
                if (lane < 32) KROPE[(size_t)kvrow * 32 + lane] = bf1(v);
            }
        } else {
            const int idx = it - M, b = idx >> 8, s = idx & 255; const int kvrow = MCTX + b * 4352 + s;
            const size_t crow_ = (size_t)(b * 4 + l) * 256 + s;
            const float* ck = a->in[3] + crow_ * 128; const float* cv = a->in[4] + crow_ * 128;
#pragma unroll
            for (int kvh = 0; kvh < 2; ++kvh) {
                KG[(size_t)kvrow * 128 + 64 * kvh + lane] = bf1(ck[64 * kvh + lane]);
                VG[(size_t)kvrow * 128 + 64 * kvh + lane] = bf1(cv[64 * kvh + lane]);
            }
            const f32x4 y = *(const f32x4*)(a->in[5] + crow_ * 256 + 4 * lane);
            u32x2 p; p.x = cvt_pk_bf16(y.x, y.y); p.y = cvt_pk_bf16(y.z, y.w); *(u32x2*)(CKV + (size_t)kvrow * 256 + 4 * lane) = p;
            if (lane < 32) KROPE[(size_t)kvrow * 32 + lane] = bf1(a->in[6][crow_ * 32 + lane]);
        }
    }
    {
        float* LA = (float*)(a->ws + WS_MLA); float* LN = (float*)(a->ws + WS_MLN); float* LS = (float*)(a->ws + WS_MLS);
        const float* gb = a->in[20] + l * 16;
        const int hi = lane >> 5, l31 = lane & 31;
        for (int u = gw; u < 2048; u += NGW) {
            int h, d, c, rowbase;
            if (u < 1024) { const int bb = u >> 5; h = (u >> 3) & 3; d = (u >> 2) & 1; c = u & 3; rowbase = bb * 256; }
            else { const int v = u - 1024; const int b = v >> 9; h = (v >> 7) & 3; d = (v >> 6) & 1; c = v & 63; rowbase = MCTX + b * 4096; }
            const int r0 = rowbase + 64 * c;
            const float* pr = PROJ + (size_t)(r0 + lane) * NIN + C_MG;
            const float li = pr[(2 * d) * 4 + h] + gb[(2 * d) * 4 + h];
            const float lf = log_sigmoid(pr[(2 * d + 1) * 4 + h] + gb[(2 * d + 1) * 4 + h]);
            float bcum;
            if (d == 0) bcum = scan_sum(lf, lane); else { const float rv = __shfl(lf, 63 - lane); bcum = __shfl(scan_sum(rv, lane), 63 - lane); }
            const float bL = __shfl(bcum, d == 0 ? 63 : 0);
            const float decay = bL - bcum + li;
            const float mloc = wave_max(decay);
            const float w = __expf(decay - mloc);
            f32x16 acc[2][2];
#pragma unroll
            for (int i = 0; i < 2; ++i)
#pragma unroll
                for (int j = 0; j < 2; ++j) acc[i][j] = f32x16{};
            float nacc0 = 0.f, nacc1 = 0.f;
            const float* kbase = PROJ + (size_t)r0 * NIN + C_MK + 64 * h + l31;
            const float* vbase = PROJ + (size_t)r0 * NIN + C_MV + 64 * h + l31;
#pragma unroll 4
            for (int j = 0; j < 32; ++j) {
                const int s = 2 * j + hi;
                const float wsv = __shfl(w, s);
                const float k0 = kbase[(size_t)s * NIN] * wsv, k1 = kbase[(size_t)s * NIN + 32] * wsv;
                const float v0 = vbase[(size_t)s * NIN], v1 = vbase[(size_t)s * NIN + 32];
                acc[0][0] = __builtin_amdgcn_mfma_f32_32x32x2f32(k0, v0, acc[0][0], 0, 0, 0);
                acc[0][1] = __builtin_amdgcn_mfma_f32_32x32x2f32(k0, v1, acc[0][1], 0, 0, 0);
                acc[1][0] = __builtin_amdgcn_mfma_f32_32x32x2f32(k1, v0, acc[1][0], 0, 0, 0);
                acc[1][1] = __builtin_amdgcn_mfma_f32_32x32x2f32(k1, v1, acc[1][1], 0, 0, 0);
                nacc0 += k0; nacc1 += k1;
            }
            nacc0 += __shfl_xor(nacc0, 32); nacc1 += __shfl_xor(nacc1, 32);
            float* Au = LA + (size_t)u * 4096;
#pragma unroll
            for (int dkb = 0; dkb < 2; ++dkb)
#pragma unroll
                for (int dvb = 0; dvb < 2; ++dvb)
#pragma unroll
                    for (int r = 0; r < 16; ++r) Au[(32 * dkb + crow(r, hi)) * 64 + 32 * dvb + l31] = acc[dkb][dvb][r];
            if (hi == 0) { LN[(size_t)u * 64 + l31] = nacc0; LN[(size_t)u * 64 + 32 + l31] = nacc1; }
            if (lane == 0) { LS[(size_t)u * 4 + 0] = bL; LS[(size_t)u * 4 + 1] = mloc; }
        }
    }
}

__device__ __forceinline__ void mlstm_scan_chain(ArgsP a, int l, int chain_is_lat, int chain, int e) {
    float* LA = (float*)(a->ws + WS_MLA); float* LN = (float*)(a->ws + WS_MLN); float* LS = (float*)(a->ws + WS_MLS);
    float C, n = 0.f, m; int nc, ubase; const int d = chain & 1, h = (chain >> 1) & 3, bb = chain >> 3;
    if (chain_is_lat) {
        const size_t sidx = ((size_t)(bb * 4 + l) * 2 + d) * 4 + h;
        C = a->in[7][sidx * 4096 + e]; if (e < 64) n = a->in[8][sidx * 64 + e]; m = a->in[9][sidx];
        nc = 64; ubase = 1024 + chain * 64;
    } else { C = 0.f; m = 0.f; nc = 4; ubase = chain * 4; }
    for (int step = 0; step < nc; ++step) {
        const int c = d == 0 ? step : nc - 1 - step; const size_t u = (size_t)(ubase + c);
        const float bL = LS[u * 4 + 0], mloc = LS[u * 4 + 1];
        const float av = LA[u * 4096 + e]; LA[u * 4096 + e] = C;
        float an = 0.f; if (e < 64) { an = LN[u * 64 + e]; LN[u * 64 + e] = n; }
        if (e == 0) LS[u * 4 + 2] = m;
        const float mnew = fmaxf(bL + m, mloc);
        const float wold = __expf(bL + m - mnew), wloc = __expf(mloc - mnew);
        C = wold * C + wloc * av; n = wold * n + wloc * an; m = mnew;
    }
    if (!chain_is_lat) {
        const size_t sidx = ((size_t)(bb * 4 + l) * 2 + d) * 4 + h;
        a->out[O_C + sidx * 4096 + e] = C; if (e < 64) a->out[O_N + sidx * 64 + e] = n; if (e == 0) a->out[O_MM + sidx] = m;
    }
}
__device__ __forceinline__ void phase_mlstm_scan(ArgsP a, int l) {
    int bxl = blockIdx.x; asm volatile("" : "+s"(bxl));
    const int NT = gridDim.x * NTHREADS, gt = bxl * NTHREADS + pg8::lt_tid();
    constexpr int NLAT = 16 * 4096, NCTX = 256 * 4096;
    for (int task = gt; task < NLAT; task += NT) mlstm_scan_chain(a, l, 1, task >> 12, task & 4095);
    if (NT > NLAT) { if (gt >= NLAT) for (int k = gt - NLAT; k < NCTX; k += NT - NLAT) mlstm_scan_chain(a, l, 0, k >> 12, k & 4095); }
    else for (int k = gt; k < NCTX; k += NT) mlstm_scan_chain(a, l, 0, k >> 12, k & 4095);
}

__device__ __forceinline__ void phase_mlstm_out(ArgsP a, int l) {
    const int tid = pg8::lt_tid(), lane = tid & 63, wave = tid >> 6, hi = lane >> 5, l31 = lane & 31;
    const int G = gridDim.x;
    const float* PROJ = (const float*)(a->ws + WS_PROJ);
    const float* LA = (const float*)(a->ws + WS_MLA); const float* LN = (const float*)(a->ws + WS_MLN); const float* LS = (const float*)(a->ws + WS_MLS);
    bf16_t* CAT = (bf16_t*)(a->ws + WS_XN);
    const float* gb = a->in[20] + l * 16; const float* onw = a->in[21] + l * 256;
    for (int u2 = wave * G + blockIdx.x; u2 < 1024; u2 += NWAVES * G) {
        int h, c, rowbase, ul0, ulstride;
        if (u2 < 512) { const int bb = u2 >> 4; h = (u2 >> 2) & 3; c = u2 & 3; rowbase = bb * 256; ul0 = ((bb * 4 + h) * 2) * 4 + c; ulstride = 4; }
        else { const int v = u2 - 512; const int b = v >> 8; h = (v >> 6) & 3; c = v & 63; rowbase = MCTX + b * 4096; ul0 = 1024 + ((b * 4 + h) * 2) * 64 + c; ulstride = 64; }
        const int r0 = rowbase + 64 * c;
        const float* prg = PROJ + (size_t)(r0 + lane) * NIN + C_MG;
#pragma unroll 1
        for (int tb = 0; tb < 2; ++tb) {
            const int tau = 32 * tb + l31;
            f32x16 hsum[2]; hsum[0] = f32x16{}; hsum[1] = f32x16{};
#pragma unroll 1
            for (int d = 0; d < 2; ++d) {
                const size_t ul = (size_t)(ul0 + d * ulstride);
                const float m_in = LS[ul * 4 + 2];
                const float* Cin = LA + ul * 4096; const float* nin = LN + ul * 64;
                const float li = prg[(2 * d) * 4 + h] + gb[(2 * d) * 4 + h];
                const float lf = log_sigmoid(prg[(2 * d + 1) * 4 + h] + gb[(2 * d + 1) * 4 + h]);
                float bcum, pm;
                if (d == 0) { bcum = scan_sum(lf, lane); pm = scan_max(li - bcum, lane); }
                else { const float rv = __shfl(lf, 63 - lane); bcum = __shfl(scan_sum(rv, lane), 63 - lane); const float ru = __shfl(li - bcum, 63 - lane); pm = __shfl(scan_max(ru, lane), 63 - lane); }
                const float uu = li - bcum;
                const float Mx = fmaxf(m_in, pm);
                const float M_t = __shfl(Mx, tau), b_t = __shfl(bcum, tau);
                const float winter = __expf(m_in - M_t);
                const float* qrow = PROJ + (size_t)(r0 + tau) * NIN + C_MQ + 64 * h + 32 * hi;
                float qn = 0.f;
#pragma unroll 1
                for (int j = 0; j < 8; ++j) { const f32x4 q4 = *(const f32x4*)(qrow + 4 * j), n4 = *(const f32x4*)(nin + 32 * hi + 4 * j); qn += (q4.x * n4.x + q4.y * n4.y) + (q4.z * n4.z + q4.w * n4.w); }
                qn = (qn + __shfl_xor(qn, 32)) * 0.125f;
                f32x16 o[2]; o[0] = f32x16{}; o[1] = f32x16{};
                float densum = 0.f;
                const float qsc = 0.125f * winter;
                {
                    const float* cbase = Cin + (size_t)(32 * hi) * 64 + l31;
#pragma unroll 1
                    for (int j = 0; j < 8; ++j) {
                        const f32x4 q4 = *(const f32x4*)(qrow + 4 * j) * qsc;
                        const float* cp = cbase + (size_t)(4 * j) * 64;
#pragma unroll
                        for (int i = 0; i < 4; ++i) {
                            o[0] = __builtin_amdgcn_mfma_f32_32x32x2f32(cp[i * 64], q4[i], o[0], 0, 0, 0);
                            o[1] = __builtin_amdgcn_mfma_f32_32x32x2f32(cp[i * 64 + 32], q4[i], o[1], 0, 0, 0);
                        }
                    }
                }
#pragma unroll 1
                for (int sb = 0; sb < 2; ++sb) {
                    const bool act = (d == 0) ? (sb <= tb) : (sb >= tb);
                    if (act) {
                        f32x16 p = f32x16{};
                        const float* krow = PROJ + (size_t)(r0 + 32 * sb + l31) * NIN + C_MK + 64 * h + 32 * hi;
#pragma unroll 1
                        for (int j = 0; j < 8; ++j) {
                            const f32x4 k4 = *(const f32x4*)(krow + 4 * j), q4 = *(const f32x4*)(qrow + 4 * j) * 0.125f;
#pragma unroll
                            for (int i = 0; i < 4; ++i) p = __builtin_amdgcn_mfma_f32_32x32x2f32(k4[i], q4[i], p, 0, 0, 0);
                        }
                        const float* vb0 = PROJ + (size_t)(r0 + 32 * sb + 4 * hi) * NIN + C_MV + 64 * h + l31;
#pragma unroll
                        for (int r = 0; r < 16; ++r) {
                            const int s = 32 * sb + crow(r, hi);
                            const float us = __shfl(uu, s);
                            const bool ok = (d == 0) ? (s <= tau) : (s >= tau);
                            const float pv = ok ? p[r] * __expf(us - M_t) : 0.f;
                            densum += pv;
                            const float* vp = vb0 + (size_t)((r & 3) + 8 * (r >> 2)) * NIN;
                            o[0] = __builtin_amdgcn_mfma_f32_32x32x2f32(vp[0], pv, o[0], 0, 0, 0);
                            o[1] = __builtin_amdgcn_mfma_f32_32x32x2f32(vp[32], pv, o[1], 0, 0, 0);
                            if ((r & 3) == 3) __builtin_amdgcn_sched_barrier(0);
                        }
                    }
                }
                densum += __shfl_xor(densum, 32);
                const float den = winter * qn + densum;
                const float dnm = fmaxf(fabsf(den), __expf(-(b_t + M_t)));
                const float inv = 1.0f / dnm;
#pragma unroll
                for (int r = 0; r < 16; ++r) { hsum[0][r] += o[0][r] * inv; hsum[1][r] += o[1][r] * inv; }
            }
            float ss = 0.f;
#pragma unroll
            for (int r = 0; r < 16; ++r) ss += hsum[0][r] * hsum[0][r] + hsum[1][r] * hsum[1][r];
            ss += __shfl_xor(ss, 32);
            const float rstd = 1.0f / sqrtf(ss * (1.0f / 64.0f) + EPS);
            const size_t row = (size_t)(r0 + tau);
            const float* mo = PROJ + row * NIN + C_MO + 64 * h;
#pragma unroll
            for (int dvb = 0; dvb < 2; ++dvb)
#pragma unroll
                for (int g = 0; g < 4; ++g) {
                    const int dv = 32 * dvb + 8 * g + 4 * hi;
                    const f32x4 og = *(const f32x4*)(mo + dv), nw4 = *(const f32x4*)(onw + 64 * h + dv);
                    float y[4];
#pragma unroll
                    for (int i = 0; i < 4; ++i) y[i] = hsum[dvb][4 * g + i] * rstd * nw4[i] * (1.0f / (1.0f + __expf(-og[i])));
                    u32x2 pk; pk.x = cvt_pk_bf16(y[0], y[1]); pk.y = cvt_pk_bf16(y[2], y[3]);
                    *(u32x2*)(CAT + row * 1024 + 384 + 64 * h + dv) = pk;
                }
        }
    }
}

template <int DQK>
__device__ __forceinline__ void attn_unit(const bf16_t* Qb, int qstride, const bf16_t* Kb, int kstride, const bf16_t* Krope, const bf16_t* Vb, int vstride, int S, bf16_t* Ob, LAS unsigned char* lds, const float* rope32, int t0) {
    constexpr int KST = DQK * 2 + 16, VST = 144, KBUF = 64 * KST, VBUF = 64 * VST, NQ = DQK / 16;
    const int tid = pg8::lt_tid(), lane = tid & 63, wave = tid >> 6, hi = lane >> 5, l31 = lane & 31;
    LAS unsigned char* Kl = lds; LAS unsigned char* Vl = lds + 2 * KBUF;
    bf16x8 q[NQ];
    { const bf16_t* qp = Qb + (size_t)(wave * 32 + l31) * qstride + 8 * hi;
#pragma unroll
      for (int i = 0; i < NQ; ++i) q[i] = *(const bf16x8*)(qp + 16 * i); }
    if constexpr (DQK == 96) {
        if (rope32) {
            const float* rp = rope32 + (size_t)(t0 + wave * 32 + l31) * 32 + 8 * hi;
            const f32x4 c0 = *(const f32x4*)(rp), c1 = *(const f32x4*)(rp + 4), s0 = *(const f32x4*)(rp + 16), s1 = *(const f32x4*)(rp + 20);
            float y1[8], y2[8];
#pragma unroll
            for (int e = 0; e < 8; ++e) {
                const float x1 = __uint_as_float(((unsigned)(unsigned short)q[4][e]) << 16), x2 = __uint_as_float(((unsigned)(unsigned short)q[5][e]) << 16);
                const float c = e < 4 ? c0[e & 3] : c1[e & 3], sn = e < 4 ? s0[e & 3] : s1[e & 3];
                y1[e] = x1 * c - x2 * sn; y2[e] = x1 * sn + x2 * c;
            }
            u32x4 w1 = u32x4{cvt_pk_bf16(y1[0], y1[1]), cvt_pk_bf16(y1[2], y1[3]), cvt_pk_bf16(y1[4], y1[5]), cvt_pk_bf16(y1[6], y1[7])};
            u32x4 w2 = u32x4{cvt_pk_bf16(y2[0], y2[1]), cvt_pk_bf16(y2[2], y2[3]), cvt_pk_bf16(y2[4], y2[5]), cvt_pk_bf16(y2[6], y2[7])};
            q[4] = __builtin_bit_cast(bf16x8, w1); q[5] = __builtin_bit_cast(bf16x8, w2);
        }
    }
    const int kkey = tid >> 3, kch = tid & 7, rkey = (tid >> 2) & 63, rch = tid & 3;
    const bf16_t* ksrc = Kb + (size_t)kkey * kstride + kch * 8;
    const bf16_t* rsrc = (DQK == 96) ? Krope + (size_t)rkey * 32 + rch * 8 : nullptr;
    const int vkey = tid & 63, vch = tid >> 6;
    const bf16_t* vsrc = Vb + (size_t)vkey * vstride + vch * 8;
    const int kdst = kkey * KST + kch * 16, rdst = rkey * KST + 128 + rch * 16, vdst = (vch * 8) * VST + vkey * 2;
    u32x4 kreg, rreg = u32x4{}, vreg;
    const int nt = S / 64;
    kreg = *(const u32x4*)ksrc; vreg = *(const u32x4*)vsrc; if (DQK == 96 && tid < 256) rreg = *(const u32x4*)rsrc;
    __syncthreads();
    *(LAS u32x4*)(Kl + kdst) = kreg; if (DQK == 96 && tid < 256) *(LAS u32x4*)(Kl + rdst) = rreg;
#define VT_STORE(buf) do { LAS unsigned short* vp_ = (LAS unsigned short*)(Vl + (buf) * VBUF + vdst); \
        vp_[0] = (unsigned short)(vreg.x & 0xffffu); vp_[VST / 2] = (unsigned short)(vreg.x >> 16); vp_[2 * (VST / 2)] = (unsigned short)(vreg.y & 0xffffu); vp_[3 * (VST / 2)] = (unsigned short)(vreg.y >> 16); \
        vp_[4 * (VST / 2)] = (unsigned short)(vreg.z & 0xffffu); vp_[5 * (VST / 2)] = (unsigned short)(vreg.z >> 16); vp_[6 * (VST / 2)] = (unsigned short)(vreg.w & 0xffffu); vp_[7 * (VST / 2)] = (unsigned short)(vreg.w >> 16); } while (0)
    VT_STORE(0);
    __syncthreads();
    float mrun = -INFINITY, lsum = 0.f;
    f32x16 o[2]; o[0] = f32x16{}; o[1] = f32x16{};
    for (int t = 0; t < nt; ++t) {
        const int cur = t & 1;
        if (t + 1 < nt) {
            kreg = *(const u32x4*)(ksrc + (size_t)(t + 1) * 64 * kstride); vreg = *(const u32x4*)(vsrc + (size_t)(t + 1) * 64 * vstride);
            if (DQK == 96 && tid < 256) rreg = *(const u32x4*)(rsrc + (size_t)(t + 1) * 64 * 32);
        }
        __builtin_amdgcn_sched_barrier(0);
        const LAS unsigned char* kb = Kl + cur * KBUF + l31 * KST + hi * 16;
        f32x16 p0 = f32x16{}, p1 = f32x16{};
#pragma unroll
        for (int i = 0; i < NQ; ++i) {
            const bf16x8 k0 = *(const LAS bf16x8*)(kb + i * 32), k1 = *(const LAS bf16x8*)(kb + 32 * KST + i * 32);
            p0 = __builtin_amdgcn_mfma_f32_32x32x16_bf16(k0, q[i], p0, 0, 0, 0);
            p1 = __builtin_amdgcn_mfma_f32_32x32x16_bf16(k1, q[i], p1, 0, 0, 0);
            if (i == 2) __builtin_amdgcn_sched_barrier(0);
        }
        __builtin_amdgcn_sched_barrier(0);
        float mx = fmaxf(p0[0], p1[0]);
#pragma unroll
        for (int r = 1; r < 16; ++r) mx = fmaxf(mx, fmaxf(p0[r], p1[r]));
        mx = fmaxf(mx, __shfl_xor(mx, 32));
        const float mnew = fmaxf(mrun, mx);
        const float alpha = __builtin_amdgcn_exp2f(mrun - mnew);
        mrun = mnew;
        float ps = 0.f;
#pragma unroll
        for (int r = 0; r < 16; ++r) { p0[r] = __builtin_amdgcn_exp2f(p0[r] - mnew); p1[r] = __builtin_amdgcn_exp2f(p1[r] - mnew); ps += p0[r] + p1[r]; }
        lsum = lsum * alpha + ps;
#pragma unroll
        for (int r = 0; r < 16; ++r) { o[0][r] *= alpha; o[1][r] *= alpha; }
        u32x4 pw[4];
        pw[0] = u32x4{cvt_pk_bf16(p0[0], p0[1]), cvt_pk_bf16(p0[2], p0[3]), cvt_pk_bf16(p0[4], p0[5]), cvt_pk_bf16(p0[6], p0[7])};
        pw[1] = u32x4{cvt_pk_bf16(p0[8], p0[9]), cvt_pk_bf16(p0[10], p0[11]), cvt_pk_bf16(p0[12], p0[13]), cvt_pk_bf16(p0[14], p0[15])};
        pw[2] = u32x4{cvt_pk_bf16(p1[0], p1[1]), cvt_pk_bf16(p1[2], p1[3]), cvt_pk_bf16(p1[4], p1[5]), cvt_pk_bf16(p1[6], p1[7])};
        pw[3] = u32x4{cvt_pk_bf16(p1[8], p1[9]), cvt_pk_bf16(p1[10], p1[11]), cvt_pk_bf16(p1[12], p1[13]), cvt_pk_bf16(p1[14], p1[15])};
        __builtin_amdgcn_sched_barrier(0);
        const LAS unsigned char* vb = Vl + cur * VBUF + l31 * VST + hi * 8;
#pragma unroll
        for (int db = 0; db < 2; ++db)
#pragma unroll
            for (int ks = 0; ks < 4; ++ks) {
                const s16x4 lo = *(const LAS s16x4*)(vb + db * 32 * VST + ks * 32), hi4 = *(const LAS s16x4*)(vb + db * 32 * VST + ks * 32 + 16);
                const bf16x8 vf = (bf16x8){lo[0], lo[1], lo[2], lo[3], hi4[0], hi4[1], hi4[2], hi4[3]};
                o[db] = __builtin_amdgcn_mfma_f32_32x32x16_bf16(vf, __builtin_bit_cast(bf16x8, pw[ks]), o[db], 0, 0, 0);
                if (ks == 3) __builtin_amdgcn_sched_barrier(0);
            }
        __builtin_amdgcn_sched_barrier(0);
        if (t + 1 < nt) {
            const int nx = cur ^ 1;
            *(LAS u32x4*)(Kl + nx * KBUF + kdst) = kreg; VT_STORE(nx); if (DQK == 96 && tid < 256) *(LAS u32x4*)(Kl + nx * KBUF + rdst) = rreg;
        }
        __syncthreads();
    }
    lsum += __shfl_xor(lsum, 32);
    const float inv = 1.0f / lsum;
    bf16_t* op = Ob + (size_t)(wave * 32 + l31) * 1024;
#pragma unroll
    for (int db = 0; db < 2; ++db)
#pragma unroll
        for (int g = 0; g < 4; ++g) {
            u32x2 pk; pk.x = cvt_pk_bf16(o[db][4 * g] * inv, o[db][4 * g + 1] * inv); pk.y = cvt_pk_bf16(o[db][4 * g + 2] * inv, o[db][4 * g + 3] * inv);
            *(u32x2*)(op + 32 * db + 8 * g + 4 * hi) = pk;
        }
#undef VT_STORE
}
__device__ __forceinline__ void phase_attention(ArgsP a, LAS unsigned char* lds) {
    unsigned char* r1 = a->ws + WS_R1;
    const bf16_t* QG = (const bf16_t*)(r1 + R1_QG); const bf16_t* KG = (const bf16_t*)(r1 + R1_KG); const bf16_t* VG = (const bf16_t*)(r1 + R1_VG);
    const bf16_t* KROPE = (const bf16_t*)(r1 + R1_KROPE); const bf16_t* QM = (const bf16_t*)(r1 + R1_QM); const bf16_t* KVM = (const bf16_t*)(r1 + R1_KVM);
    bf16_t* CAT = (bf16_t*)(a->ws + WS_XN);
    for (int ui = blockIdx.x; ui < 768; ui += gridDim.x) {
        const int kind = ui / 192, v = ui % 192;
        if (kind == 0) {
            const int b = v / 96, h = (v / 16) % 6, qb = v & 15; const size_t row0 = MCTX + (size_t)b * 4096 + qb * 256, kv0 = MCTX + (size_t)b * 4352;
            attn_unit<96>(QM + row0 * 768 + h * 96, 768, KVM + kv0 * 768 + h * 128, 768, KROPE + kv0 * 32, KVM + kv0 * 768 + h * 128 + 64, 768, 4352, CAT + row0 * 1024 + 640 + h * 64, lds, (const float*)(a->ws + WS_ROPE32), qb * 256);
        } else if (kind == 1) {
            const int b = v / 96, kvh = (v / 48) & 1, g = (v / 16) % 3, qb = v & 15, hq = kvh * 3 + g; const size_t row0 = MCTX + (size_t)b * 4096 + qb * 256, kv0 = MCTX + (size_t)b * 4352;
            attn_unit<64>(QG + row0 * 384 + hq * 64, 384, KG + kv0 * 128 + kvh * 64, 128, nullptr, VG + kv0 * 128 + kvh * 64, 128, 4352, CAT + row0 * 1024 + hq * 64, lds, nullptr, 0);
        } else if (kind == 2) {
            const int b = v / 6, h = v % 6; const size_t row0 = (size_t)b * 256;
            attn_unit<96>(QM + row0 * 768 + h * 96, 768, KVM + row0 * 768 + h * 128, 768, KROPE + row0 * 32, KVM + row0 * 768 + h * 128 + 64, 768, 256, CAT + row0 * 1024 + 640 + h * 64, lds, nullptr, 0);
        } else {
            const int b = v / 6, hq = v % 6, kvh = hq / 3; const size_t row0 = (size_t)b * 256;
            attn_unit<64>(QG + row0 * 384 + hq * 64, 384, KG + row0 * 128 + kvh * 64, 128, nullptr, VG + row0 * 128 + kvh * 64, 128, 256, CAT + row0 * 1024 + hq * 64, lds, nullptr, 0);
        }
    }
}

__global__ void __launch_bounds__(NTHREADS, 2) mk_fwd(Args a_in) {
    extern __shared__ __attribute__((aligned(16))) unsigned char lds_raw[];
    LAS unsigned char* lds = (LAS unsigned char*)lds_raw;
    cg::grid_group grid = cg::this_grid();
    const int G = gridDim.x;
    for (int ph = a_in.ph_lo; ph < a_in.ph_hi; ++ph) {
        ArgsP a = (ArgsP)__builtin_amdgcn_kernarg_segment_ptr(); asm volatile("" : "+s"(a));
        unsigned char* ws = a->ws;
        int bx = blockIdx.x; asm volatile("" : "+s"(bx));
        if (ph == 0) { if (PHM & 1) phase_prologue(a, lds); }
        else if (ph == 49) { if (PHM & 2) phase_final_norm(a); }
        else {
            const int l = (ph - 1) / 12, sp = (ph - 1) % 12;
            const float* mods = (const float*)(ws + WS_MODS) + (size_t)l * 3 * 9216;
            if (sp == 0 || sp == 3 || sp == 9) { if (PHM & 2) phase_norm(a, l, sp == 0 ? 0 : sp == 3 ? 1 : 2); }
            else if ((PHM & 4) && (sp == 1 || sp == 10)) {
                const int j = sp == 1 ? 0 : 1;
                pg8::Gemm g{(const bf16_t*)(ws + WS_XN), (const bf16_t*)(ws + WS_WGU + (size_t)(l * 2 + j) * SZ_WGU1), M, NGU, DM};
                pg8::StaticOrder S; S.init(M, NGU, G, bx);
                pg8::EpiSwiGLU E{(bf16_t*)(ws + WS_R1)};
                pg8::gemm_phase<pg8::EpiSwiGLU, pg8::StaticOrder, true, true>(lds, g, S, E);
            } else if ((PHM & 8) && (sp == 2 || sp == 11)) {
                const int j = sp == 2 ? 0 : 1;
                pg8::Gemm g{(const bf16_t*)(ws + WS_R1), (const bf16_t*)(ws + WS_WD + (size_t)(l * 2 + j) * SZ_WD1), M, DM, FF};
                pg8::StaticOrder S; S.init(M, DM, G, bx);
                pg8::EpiResid E{(const float*)(ws + WS_X), (float*)(ws + WS_X), mods + (j == 0 ? 2 : 8) * 1024, 0.5f};
                pg8::gemm_phase<pg8::EpiResid, pg8::StaticOrder, true, true>(lds, g, S, E);
            } else if ((PHM & 16) && sp == 4) {
                pg8::Gemm g{(const bf16_t*)(ws + WS_XN), (const bf16_t*)(ws + WS_WIN + (size_t)l * SZ_WIN1), M, NIN, DM};
                pg8::StaticOrder S; S.init(M, NIN, G, bx);
                pg8::EpiF32 E{(float*)(ws + WS_PROJ), NIN};
                pg8::gemm_phase<pg8::EpiF32, pg8::StaticOrder, true, true>(lds, g, S, E);
            } else if (sp == 5) { if (PHM & 32) phase_prep(a, l); }
            else if (sp == 6) {
                int k256 = 256; asm volatile("" : "+s"(k256));
                if (PHM & 64) {
                    pg8::Gemm g{(const bf16_t*)(ws + WS_R1 + R1_QLATN), (const bf16_t*)(ws + WS_WUQ + (size_t)l * SZ_WUQ1), M, 768, k256};
                    pg8::StaticOrder S; S.init(M, 768, G, bx);
                    pg8::EpiBf16S E{(bf16_t*)(ws + WS_R1 + R1_QM), 768, 0.10206207261596575f * LOG2E};
                    pg8::gemm_phase<pg8::EpiBf16S, pg8::StaticOrder, true, true>(lds, g, S, E);
                }
                if (PHM & 128) {
                    pg8::Gemm g{(const bf16_t*)(ws + WS_R1 + R1_CKV), (const bf16_t*)(ws + WS_WUKV + (size_t)l * SZ_WUKV1), KVROWS, 768, k256};
                    pg8::StaticOrder S; S.init(KVROWS, 768, G, bx);
                    pg8::EpiBf16S E{(bf16_t*)(ws + WS_R1 + R1_KVM), 768, 1.0f};
                    pg8::gemm_phase<pg8::EpiBf16S, pg8::StaticOrder, true, true>(lds, g, S, E);
                }
                if (PHM & 256) phase_mlstm_scan(a, l);
            } else if (sp == 7) { if (PHM & 512) phase_mlstm_out(a, l); if (PHM & 1024) phase_attention(a, lds); }
            else if ((PHM & 2048) && sp == 8) {
                pg8::Gemm g{(const bf16_t*)(ws + WS_XN), (const bf16_t*)(ws + WS_WOUT + (size_t)l * SZ_WOUT1), M, DM, DM};
                pg8::StaticOrder S; S.init(M, DM, G, bx);
                pg8::EpiResid E{(const float*)(ws + WS_X), (float*)(ws + WS_X), mods + 5 * 1024, 1.0f};
                pg8::gemm_phase<pg8::EpiResid, pg8::StaticOrder, true, true>(lds, g, S, E);
            }
        }
        if (ph + 1 < a_in.ph_hi) grid.sync();
    }
}

extern "C" void kernel_launch(void* const* d_in, const int* in_sizes, int n_in, void* d_out, int out_size, void* d_ws, size_t ws_size, hipStream_t stream) {
    static int grid = 0;
    if (grid == 0) {
        if (n_in != 28 || ws_size < WS_END) { fprintf(stderr, "kernel_launch: unexpected n_in %d or ws_size %zu (< %zu)\n", n_in, ws_size, (size_t)WS_END); grid = -1; return; }
        int dev = 0, cus = 0, per_cu = 0;
        hipGetDevice(&dev); hipDeviceGetAttribute(&cus, hipDeviceAttributeMultiprocessorCount, dev);
        hipFuncSetAttribute((const void*)mk_fwd, hipFuncAttributeMaxDynamicSharedMemorySize, LDS_BYTES);
        hipOccupancyMaxActiveBlocksPerMultiprocessor(&per_cu, (const void*)mk_fwd, NTHREADS, LDS_BYTES);
        (void)hipGetLastError();
        if (per_cu < 1) per_cu = 1;
        grid = cus;
        if (grid <= 0) grid = 256;
    }
    if (grid < 0) return;
    Args a{};
    for (int i = 0; i < 28; ++i) a.in[i] = (const float*)d_in[i];
    a.out = (float*)d_out; a.ws = (unsigned char*)d_ws;
#if MK_MULTI_LAUNCH
    for (int ph = 0; ph < 50; ++ph) { a.ph_lo = ph; a.ph_hi = ph + 1; hipLaunchKernelGGL(mk_fwd, dim3(grid), dim3(NTHREADS), LDS_BYTES, stream, a); }
#else
    a.ph_lo = 0; a.ph_hi = 50;
    void* args[] = {&a};
    hipError_t e = hipLaunchCooperativeKernel((const void*)mk_fwd, dim3(grid), dim3(NTHREADS), args, LDS_BYTES, stream);
    if (e != hipSuccess) fprintf(stderr, "cooperative launch failed: %s (grid %d)\n", hipGetErrorString(e), grid);
#endif
}
```

```cpp
#include <hip/hip_runtime.h>
#include <hip/hip_cooperative_groups.h>
#include <cstdio>
#include <cstdint>
namespace cg = cooperative_groups;

#ifndef MK_MULTI_LAUNCH
#define MK_MULTI_LAUNCH 0
#endif
namespace pg8 {
#define PG8_LAS __attribute__((address_space(3)))
__device__ __forceinline__ int lt_tid() { int t = threadIdx.x; asm volatile("" : "+v"(t)); return t; }
typedef unsigned short bf16_t;
typedef short bf16x8 __attribute__((ext_vector_type(8)));
typedef float f32x4 __attribute__((ext_vector_type(4)));
typedef unsigned u32x4 __attribute__((ext_vector_type(4)));
constexpr int BM = 256, BK = 64, HALF = 128, HTB = HALF * BK * 2  , STAGE_BYTES = 8 * HTB, NXCD = 8, WGM = 8;

__host__ __device__ __forceinline__ int lds_byte(int r, int c) { const int st = (r >> 4) * 2 + (c >> 5), rr = r & 15, cc = c & 31, ob = rr * 64 + cc * 2; return st * 1024 + (ob ^ (((ob >> 9) & 1) << 5)); }
__host__ __device__ __forceinline__ void stage_rc(int b, int& R, int& C) { const int st = b / 1024, sb = b % 1024, swz = sb ^ (((sb >> 9) & 1) << 5); R = (st >> 1) * 16 + swz / 64; C = (st & 1) * 32 + (swz % 64) / 2; }
__host__ __device__ __forceinline__ int perm32(int rho) { const int n = rho >> 4, i = rho & 15; return 8 * (i >> 2) + 4 * n + (i & 3); }

struct Unit { int pm, pn; };
struct Gemm { const bf16_t* A; const bf16_t* Bt; int M, N, K; };

struct StaticOrder {
    int nM, nN, nwg, G, c;
    __host__ __device__ void init(int M, int N, int G_, int c_) { nM = M / BM; nN = N / BM; nwg = nM * nN; G = G_; c = c_; }
    __host__ __device__ bool next(int i, Unit& u) const {
        const long L = (long)i * G + c; if (L >= nwg) return false;
        int wgid = (int)L; { const int q = nwg / NXCD, r = nwg % NXCD, xcd = wgid % NXCD, off = wgid / NXCD; wgid = (xcd < r ? xcd * (q + 1) : r * (q + 1) + (xcd - r) * q) + off; }
        const int nig = WGM * nN, gid = wgid / nig, fm = gid * WGM, gsz = (nM - fm) < WGM ? (nM - fm) : WGM;
        u.pm = fm + ((wgid % nig) % gsz); u.pn = (wgid % nig) / gsz; return true;
    }
    __device__ __forceinline__ void a_ready(const Unit&) const {}
    __device__ __forceinline__ void done(const Unit&) const {}
};

__device__ __forceinline__ unsigned cvt_pk_bf16(float lo, float hi) { unsigned r; asm volatile("v_cvt_pk_bf16_f32 %0, %1, %2" : "=v"(r) : "v"(lo), "v"(hi)); return r; }
typedef float f32x2 __attribute__((ext_vector_type(2)));
typedef unsigned u32x2 __attribute__((ext_vector_type(2)));
__device__ __forceinline__ float silu_f(float x) { return x * __builtin_amdgcn_rcpf(1.0f + __expf(-x)); }

struct EpiSwiGLU {
    static constexpr bool PERM = true, AFTER_DRAIN = false;
    bf16_t* O;
    __device__ __forceinline__ void operator()(const f32x4 (&acc)[2][2][4][2], const Unit& u, int wr, int wc, int fr, int fq) const {
        const int row0 = u.pm * BM + wr * 64 + fr, col0 = u.pn * 128 + wc * 32 + 8 * fq;
#pragma unroll
        for (int ai = 0; ai < 2; ++ai)
#pragma unroll
            for (int m = 0; m < 4; ++m) {
                bf16_t* rowp = O + (size_t)(row0 + ai * HALF + m * 16) * 2816 + col0;
                const f32x4 g0 = acc[ai][0][m][0], g1 = acc[ai][0][m][1], u0 = acc[ai][1][m][0], u1 = acc[ai][1][m][1];
                u32x4 w;
                w.x = cvt_pk_bf16(silu_f(g0[0]) * u0[0], silu_f(g0[1]) * u0[1]); w.y = cvt_pk_bf16(silu_f(g0[2]) * u0[2], silu_f(g0[3]) * u0[3]);
                w.z = cvt_pk_bf16(silu_f(g1[0]) * u1[0], silu_f(g1[1]) * u1[1]); w.w = cvt_pk_bf16(silu_f(g1[2]) * u1[2], silu_f(g1[3]) * u1[3]);
                *(u32x4*)rowp = w;
            }
    }
};
struct EpiResid {
    static constexpr bool PERM = false, AFTER_DRAIN = false;
    const float* base; float* out; const float* gmod; float gs;
    __device__ __forceinline__ void operator()(const f32x4 (&acc)[2][2][4][2], const Unit& u, int wr, int wc, int fr, int fq) const {
        const int row0 = u.pm * BM + wr * 64 + fr, col0 = u.pn * BM + wc * 32 + 4 * fq;
        const int cond = u.pm < 32 ? 0 : 1 + ((u.pm - 32) >> 4);
        const float* g = gmod + cond * 9216;
#pragma unroll
        for (int bj = 0; bj < 2; ++bj)
#pragma unroll
            for (int n = 0; n < 2; ++n) {
                const f32x4 gv = *(const f32x4*)(g + col0 + bj * HALF + n * 16) * gs;
#pragma unroll
                for (int ai = 0; ai < 2; ++ai)
#pragma unroll
                    for (int m = 0; m < 4; ++m) {
                        const size_t off = (size_t)(row0 + ai * HALF + m * 16) * 1024 + col0 + bj * HALF + n * 16;
                        *(f32x4*)(out + off) = *(const f32x4*)(base + off) + gv * acc[ai][bj][m][n];
                    }
            }
    }
};
struct EpiF32 {
    static constexpr bool PERM = false, AFTER_DRAIN = false;
    float* out; int ldc;
    __device__ __forceinline__ void operator()(const f32x4 (&acc)[2][2][4][2], const Unit& u, int wr, int wc, int fr, int fq) const {
        const int row0 = u.pm * BM + wr * 64 + fr, col0 = u.pn * BM + wc * 32 + 4 * fq;
#pragma unroll
        for (int ai = 0; ai < 2; ++ai)
#pragma unroll
            for (int m = 0; m < 4; ++m)
#pragma unroll
                for (int bj = 0; bj < 2; ++bj)
#pragma unroll
                    for (int n = 0; n < 2; ++n)
                        *(f32x4*)(out + (size_t)(row0 + ai * HALF + m * 16) * ldc + col0 + bj * HALF + n * 16) = acc[ai][bj][m][n];
    }
};
struct EpiBf16S {
    static constexpr bool PERM = true, AFTER_DRAIN = false;
    bf16_t* O; int ldc; float scale;
    __device__ __forceinline__ void operator()(const f32x4 (&acc)[2][2][4][2], const Unit& u, int wr, int wc, int fr, int fq) const {
        const int row0 = u.pm * BM + wr * 64 + fr, col0 = u.pn * BM + wc * 32 + 8 * fq;
#pragma unroll
        for (int ai = 0; ai < 2; ++ai)
#pragma unroll
            for (int m = 0; m < 4; ++m) {
                bf16_t* rowp = O + (size_t)(row0 + ai * HALF + m * 16) * ldc + col0;
#pragma unroll
                for (int bj = 0; bj < 2; ++bj) {
                    const f32x4 v0 = acc[ai][bj][m][0] * scale, v1 = acc[ai][bj][m][1] * scale;
                    u32x4 w; w.x = cvt_pk_bf16(v0[0], v0[1]); w.y = cvt_pk_bf16(v0[2], v0[3]); w.z = cvt_pk_bf16(v1[0], v1[1]); w.w = cvt_pk_bf16(v1[2], v1[3]);
                    *(u32x4*)(rowp + bj * HALF) = w;
                }
            }
    }
};
template <class Epi, class Sched, bool ALIGN_EPI = false, bool SP2 = false>
__device__ __forceinline__ void gemm_phase(PG8_LAS unsigned char* lds, const Gemm g, const Sched& S, const Epi& E) {
    const int tid = lt_tid(), wid = __builtin_amdgcn_readfirstlane(tid >> 6), lane = tid & 63, wr = wid >> 2, wc = wid & 3, fr = lane & 15, fq = lane >> 4;
    const int K = g.K, nt = K / BK;
    unsigned voffA[2], voffB[2];
#pragma unroll
    for (int i = 0; i < 2; ++i) { int R, C; stage_rc(tid * 16 + i * 8192, R, C); const int Rb = Epi::PERM ? ((R & ~31) + perm32(R & 31)) : R;
        voffA[i] = (unsigned)(R * K + C) * 2u; voffB[i] = (unsigned)(Rb * K + C) * 2u; }
    const size_t kstep = (size_t)(BK * 2);
    const size_t hstep = (size_t)HALF * K * 2;
    const size_t tstep = 2 * hstep;
    const unsigned ldsw = (unsigned)wid * 1024u;
    const int aoff = lds_byte(wr * 64 + fr, fq * 8), boff = lds_byte(wc * 32 + fr, fq * 8);
#define PG8_SA(b, h) (((b) * 2 + (h)) * HTB)
#define PG8_SB(b, h) ((4 + (b) * 2 + (h)) * HTB)
#define PG8_STAGE(bufoff, gbase, voff) do { _Pragma("unroll") for (int _i = 0; _i < 2; ++_i) \
        __builtin_amdgcn_global_load_lds((const unsigned*)((const char*)(gbase) + (voff)[_i]), (PG8_LAS unsigned*)(lds + (bufoff) + ldsw + _i * 8192), 16, 0, 0); } while (0)
#define PG8_LDA(dst, b, h) do { _Pragma("unroll") for (int m = 0; m < 4; ++m) _Pragma("unroll") for (int k = 0; k < 2; ++k) dst[m][k] = *(const PG8_LAS bf16x8*)(lds + PG8_SA(b, h) + aoff + m * 2048 + k * 1024); } while (0)
#define PG8_LDB(dst, b, h) do { _Pragma("unroll") for (int n = 0; n < 2; ++n) _Pragma("unroll") for (int k = 0; k < 2; ++k) dst[n][k] = *(const PG8_LAS bf16x8*)(lds + PG8_SB(b, h) + boff + n * 2048 + k * 1024); } while (0)
#define PG8_MMA(ai, bj, At, Bt) do { __builtin_amdgcn_s_setprio(1); _Pragma("unroll") for (int m = 0; m < 4; ++m) _Pragma("unroll") for (int n = 0; n < 2; ++n) _Pragma("unroll") for (int k = 0; k < 2; ++k) \
        acc[ai][bj][m][n] = __builtin_amdgcn_mfma_f32_16x16x32_bf16(Bt[n][k], At[m][k], acc[ai][bj][m][n], 0, 0, 0); __builtin_amdgcn_s_setprio(0); } while (0)
#define PG8_WAIT_V(n) asm volatile("s_waitcnt vmcnt(" #n ")" ::: "memory")
#define PG8_WAIT_L(n) asm volatile("s_waitcnt lgkmcnt(" #n ")" ::: "memory")
#define PG8_BAR __builtin_amdgcn_s_barrier()
#define PG8_SCHED __builtin_amdgcn_sched_barrier(0)
    Unit cur, nxt; int ui = 0;
    if (!S.next(0, cur)) return;
    f32x4 acc[2][2][4][2];
#pragma unroll
    for (int a = 0; a < 2; ++a)
#pragma unroll
        for (int b = 0; b < 2; ++b)
#pragma unroll
            for (int m = 0; m < 4; ++m)
#pragma unroll
                for (int n = 0; n < 2; ++n) acc[a][b][m][n] = (f32x4){0.f, 0.f, 0.f, 0.f};
    bf16x8 At[4][2], B0[2][2], B1[2][2];
    const char* cA = (const char*)g.A + (size_t)cur.pm * tstep; const char* cB = (const char*)g.Bt + (size_t)cur.pn * tstep;
    S.a_ready(cur);
    if constexpr (SP2) {
        PG8_STAGE(PG8_SB(0, 0), cB, voffB); PG8_STAGE(PG8_SB(0, 1), cB + hstep, voffB); PG8_STAGE(PG8_SA(0, 0), cA, voffA); PG8_STAGE(PG8_SA(0, 1), cA + hstep, voffA);
        if (wr == 1) PG8_BAR;
        PG8_WAIT_V(2); PG8_BAR;
        PG8_STAGE(PG8_SB(1, 0), cB + kstep, voffB); PG8_STAGE(PG8_SA(1, 0), cA + kstep, voffA); PG8_STAGE(PG8_SB(1, 1), cB + hstep + kstep, voffB);
        PG8_WAIT_V(6); PG8_BAR;
    } else {
        PG8_STAGE(PG8_SB(0, 0), cB, voffB); PG8_STAGE(PG8_SA(0, 0), cA, voffA); PG8_STAGE(PG8_SB(0, 1), cB + hstep, voffB); PG8_STAGE(PG8_SA(0, 1), cA + hstep, voffA);
        if (wr == 1) PG8_BAR;
        PG8_WAIT_V(4); PG8_BAR;
        PG8_STAGE(PG8_SB(1, 0), cB + kstep, voffB); PG8_STAGE(PG8_SA(1, 0), cA + kstep, voffA); PG8_STAGE(PG8_SB(1, 1), cB + hstep + kstep, voffB);
        PG8_WAIT_V(6); PG8_BAR;
    }
    for (;;) {
        const bool has_next = S.next(ui + 1, nxt);
        const char* nA = has_next ? (const char*)g.A + (size_t)nxt.pm * tstep : cA; const char* nB = has_next ? (const char*)g.Bt + (size_t)nxt.pn * tstep : cB;
        for (int t = 0; t < nt; t += 2) {
            const bool last = (t == nt - 2);
            const char* a1 = cA + (size_t)(t + 1) * kstep;
            const char* a2 = last ? nA : cA + (size_t)(t + 2) * kstep; const char* b2 = last ? nB : cB + (size_t)(t + 2) * kstep;
            const char* a3 = a2 + kstep; const char* b3 = b2 + kstep;
            if (last && has_next) S.a_ready(nxt);
            if constexpr (SP2) {
            PG8_LDB(B0, 0, 0); PG8_LDB(B1, 0, 1); PG8_SCHED; PG8_LDA(At, 0, 0); PG8_STAGE(PG8_SA(1, 1), a1 + hstep, voffA);
            PG8_WAIT_V(8); PG8_WAIT_L(0); PG8_BAR; PG8_MMA(0, 0, At, B0); PG8_MMA(0, 1, At, B1); PG8_BAR; PG8_SCHED;
            PG8_LDA(At, 0, 1); PG8_STAGE(PG8_SB(0, 0), b2, voffB); PG8_STAGE(PG8_SB(0, 1), b2 + hstep, voffB); PG8_STAGE(PG8_SA(0, 0), a2, voffA);
            PG8_WAIT_V(8); PG8_WAIT_L(0); PG8_BAR; PG8_MMA(1, 0, At, B0); PG8_MMA(1, 1, At, B1); PG8_BAR; PG8_SCHED;
            PG8_LDB(B0, 1, 0); PG8_LDB(B1, 1, 1); PG8_SCHED; PG8_LDA(At, 1, 0); PG8_STAGE(PG8_SA(0, 1), a2 + hstep, voffA);
            PG8_WAIT_V(8); PG8_WAIT_L(0); PG8_BAR; PG8_MMA(0, 0, At, B0); PG8_MMA(0, 1, At, B1); PG8_BAR; PG8_SCHED;
            PG8_LDA(At, 1, 1); PG8_STAGE(PG8_SB(1, 0), b3, voffB); PG8_STAGE(PG8_SB(1, 1), b3 + hstep, voffB); PG8_STAGE(PG8_SA(1, 0), a3, voffA);
            PG8_WAIT_V(8); PG8_WAIT_L(0); PG8_BAR; PG8_MMA(1, 0, At, B0); PG8_MMA(1, 1, At, B1); PG8_BAR; PG8_SCHED;
            } else {
            PG8_LDB(B0, 0, 0); PG8_SCHED; PG8_LDA(At, 0, 0); PG8_STAGE(PG8_SA(1, 1), a1 + hstep, voffA);
            PG8_WAIT_L(8); PG8_BAR; PG8_WAIT_L(0); PG8_MMA(0, 0, At, B0); PG8_BAR; PG8_SCHED;
            PG8_LDB(B1, 0, 1); PG8_STAGE(PG8_SB(0, 0), b2, voffB);
            PG8_BAR; PG8_WAIT_L(0); PG8_MMA(0, 1, At, B1); PG8_BAR;
            PG8_LDA(At, 0, 1); PG8_STAGE(PG8_SA(0, 0), a2, voffA);
            PG8_BAR; PG8_WAIT_L(0); PG8_MMA(1, 0, At, B0); PG8_BAR; PG8_SCHED;
            PG8_STAGE(PG8_SB(0, 1), b2 + hstep, voffB);
            PG8_WAIT_V(6); PG8_BAR; PG8_MMA(1, 1, At, B1); PG8_BAR;
            PG8_LDB(B0, 1, 0); PG8_SCHED; PG8_LDA(At, 1, 0); PG8_STAGE(PG8_SA(0, 1), a2 + hstep, voffA);
            PG8_WAIT_L(8); PG8_BAR; PG8_WAIT_L(0); PG8_MMA(0, 0, At, B0); PG8_BAR; PG8_SCHED;
            PG8_LDB(B1, 1, 1); PG8_STAGE(PG8_SB(1, 0), b3, voffB);
            PG8_BAR; PG8_WAIT_L(0); PG8_MMA(0, 1, At, B1); PG8_BAR;
            PG8_LDA(At, 1, 1); PG8_STAGE(PG8_SA(1, 0), a3, voffA);
            PG8_BAR; PG8_WAIT_L(0); PG8_MMA(1, 0, At, B0); PG8_BAR; PG8_SCHED;
            PG8_STAGE(PG8_SB(1, 1), b3 + hstep, voffB);
            PG8_WAIT_V(6); PG8_BAR; PG8_MMA(1, 1, At, B1); PG8_BAR;
            }
        }
        if constexpr (ALIGN_EPI) { if (wr == 0) PG8_BAR; }
        if constexpr (!Epi::AFTER_DRAIN) { E(acc, cur, wr, wc, fr, fq); S.done(cur); }
        if (!has_next) break;
#pragma unroll
        for (int a = 0; a < 2; ++a)
#pragma unroll
            for (int b = 0; b < 2; ++b)
#pragma unroll
                for (int m = 0; m < 4; ++m)
#pragma unroll
                    for (int n = 0; n < 2; ++n) acc[a][b][m][n] = (f32x4){0.f, 0.f, 0.f, 0.f};
        cur = nxt; cA = nA; cB = nB; ++ui;
        if constexpr (ALIGN_EPI) { if (wr == 1) PG8_BAR; }
    }
    PG8_WAIT_V(0);
    if constexpr (!ALIGN_EPI) { if (wr == 0) PG8_BAR; }
    PG8_BAR;
    if constexpr (Epi::AFTER_DRAIN) { E.fused(acc, cur, wr, wc, fr, fq, lds, wid, lane); S.done(cur); }
#undef PG8_SA
#undef PG8_SB
#undef PG8_STAGE
#undef PG8_LDA
#undef PG8_LDB
#undef PG8_MMA
#undef PG8_WAIT_V
#undef PG8_WAIT_L
#undef PG8_BAR
#undef PG8_SCHED
}
}
#define LAS __attribute__((address_space(3)))
typedef unsigned short bf16_t;
typedef short bf16x8 __attribute__((ext_vector_type(8)));
typedef short s16x4 __attribute__((ext_vector_type(4)));
typedef float f32x4 __attribute__((ext_vector_type(4)));
typedef float f32x16 __attribute__((ext_vector_type(16)));
typedef unsigned u32x4 __attribute__((ext_vector_type(4)));
typedef unsigned u32x2 __attribute__((ext_vector_type(2)));
using pg8::cvt_pk_bf16;

#ifndef MK_PHM
#define MK_PHM 0xFFFF
#endif
constexpr int PHM = MK_PHM;
#ifndef MK_DUPM
#define MK_DUPM 0
#endif
constexpr int DUPM = MK_DUPM;
constexpr int NTHREADS = 512, NWAVES = 8;
constexpr int M = 16384, MCTX = 8192, DM = 1024, FF = 2816, NGU = 2 * FF, DIN = 2224, NIN = 2304, KVROWS = 16896, NLAYER = 4;
constexpr float EPS = 1e-6f, LOG2E = 1.4426950408889634f;
constexpr int LDS_BYTES = 131072 + 1024;

constexpr size_t al256(size_t x) { return (x + 255) & ~(size_t)255; }
constexpr size_t SZ_WGU1 = (size_t)NGU * DM * 2, SZ_WD1 = (size_t)DM * FF * 2, SZ_WIN1 = (size_t)NIN * DM * 2, SZ_WOUT1 = (size_t)DM * DM * 2, SZ_WUQ1 = (size_t)768 * 256 * 2, SZ_WUKV1 = (size_t)768 * 256 * 2;
constexpr size_t WS_WGU = 0;
constexpr size_t WS_WD = WS_WGU + 8 * SZ_WGU1;
constexpr size_t WS_WIN = WS_WD + 8 * SZ_WD1;
constexpr size_t WS_WOUT = WS_WIN + 4 * SZ_WIN1;
constexpr size_t WS_WUQ = WS_WOUT + 4 * SZ_WOUT1;
constexpr size_t WS_WUKV = WS_WUQ + 4 * SZ_WUQ1;
constexpr size_t WS_MODS = WS_WUKV + 4 * SZ_WUKV1;
constexpr size_t WS_ROPE64 = WS_MODS + al256((size_t)4 * 3 * 9216 * 4);
constexpr size_t WS_ROPE32 = WS_ROPE64 + (size_t)4096 * 64 * 4;
constexpr size_t WS_X = WS_ROPE32 + (size_t)4096 * 32 * 4;
constexpr size_t WS_XN = WS_X + (size_t)M * DM * 4;
constexpr size_t WS_R1 = WS_XN + (size_t)M * DM * 2;
constexpr size_t SZ_R1 = (size_t)M * FF * 2;
constexpr size_t WS_PROJ = WS_R1 + SZ_R1;
constexpr size_t WS_MLA = WS_PROJ + (size_t)M * NIN * 4;
constexpr size_t WS_MLN = WS_MLA + (size_t)2048 * 4096 * 4;
constexpr size_t WS_MLS = WS_MLN + (size_t)2048 * 64 * 4;
constexpr size_t WS_END = WS_MLS + (size_t)2048 * 4 * 4;
constexpr size_t R1_QG = 0;
constexpr size_t R1_KG = R1_QG + (size_t)M * 384 * 2;
constexpr size_t R1_VG = R1_KG + (size_t)KVROWS * 128 * 2;
constexpr size_t R1_QLATN = R1_VG + (size_t)KVROWS * 128 * 2;
constexpr size_t R1_CKV = R1_QLATN + (size_t)M * 256 * 2;
constexpr size_t R1_KROPE = R1_CKV + (size_t)KVROWS * 256 * 2;
constexpr size_t R1_QM = R1_KROPE + (size_t)KVROWS * 32 * 2;
constexpr size_t R1_KVM = R1_QM + (size_t)M * 768 * 2;
constexpr size_t R1_END = R1_KVM + (size_t)KVROWS * 768 * 2;
static_assert(R1_END <= SZ_R1, "mixer overlay fits in the ACT region");
static_assert(R1_KG % 256 == 0 && R1_VG % 256 == 0 && R1_QLATN % 256 == 0 && R1_CKV % 256 == 0 && R1_KROPE % 256 == 0 && R1_QM % 256 == 0 && R1_KVM % 256 == 0, "alignment");
static_assert(WS_MODS % 256 == 0 && WS_X % 256 == 0 && WS_R1 % 256 == 0 && WS_PROJ % 256 == 0, "alignment");

constexpr size_t O_YP = 0, O_YS = 8388608, O_GK = 16777216, O_GV = 20971520, O_CKV = 25165824, O_KR = 33554432, O_C = 34603008, O_N = 38797312, O_MM = 38862848;
constexpr int C_GQ = 0, C_GK = 384, C_GV = 512, C_MQ = 640, C_MK = 896, C_MV = 1152, C_MO = 1408, C_MG = 1664, C_QLAT = 1680, C_KVLAT = 1936, C_KROPE = 2192;

struct Args { const float* in[28]; float* out; unsigned char* ws; int ph_lo, ph_hi; };
typedef const __attribute__((address_space(4))) Args* ArgsP;

__device__ __forceinline__ float wave_sum(float v) {
#pragma unroll
    for (int o = 1; o < 64; o <<= 1) v += __shfl_xor(v, o);
    return v;
}
__device__ __forceinline__ float wave_max(float v) {
#pragma unroll
    for (int o = 1; o < 64; o <<= 1) v = fmaxf(v, __shfl_xor(v, o));
    return v;
}
__device__ __forceinline__ unsigned short bf1(float v) { return (unsigned short)(cvt_pk_bf16(v, 0.f) & 0xffffu); }
__device__ __forceinline__ int crow(int r, int hi) { return (r & 3) + 8 * (r >> 2) + 4 * hi; }
__device__ __forceinline__ float log_sigmoid(float x) { return fminf(x, 0.f) - log1pf(__expf(-fabsf(x))); }
__device__ __forceinline__ float scan_sum(float v, int lane) {
#pragma unroll
    for (int o = 1; o < 64; o <<= 1) { const float t = __shfl_up(v, o); if (lane >= o) v += t; }
    return v;
}
__device__ __forceinline__ float scan_max(float v, int lane) {
#pragma unroll
    for (int o = 1; o < 64; o <<= 1) { const float t = __shfl_up(v, o); if (lane >= o) v = fmaxf(v, t); }
    return v;
}

__device__ __forceinline__ void transpose_item(const float* W, int K, int N, bf16_t* WT, int dst_row0, int k0, int n0, LAS float* scr, int lane) {
    const int nn = n0 + (lane & 31);
#pragma unroll 8
    for (int i = 0; i < 32; ++i) { const int kk = 2 * i + (lane >> 5); scr[kk * 33 + (lane & 31)] = (nn < N) ? W[(size_t)(k0 + kk) * N + nn] : 0.f; }
    asm volatile("s_waitcnt lgkmcnt(0)" ::: "memory");
    const int c = lane & 7;
#pragma unroll
    for (int j = 0; j < 4; ++j) {
        const int n = (lane >> 3) + 8 * j; const LAS float* s = scr + (8 * c) * 33 + n;
        u32x4 o; o.x = cvt_pk_bf16(s[0 * 33], s[1 * 33]); o.y = cvt_pk_bf16(s[2 * 33], s[3 * 33]); o.z = cvt_pk_bf16(s[4 * 33], s[5 * 33]); o.w = cvt_pk_bf16(s[6 * 33], s[7 * 33]);
        *(u32x4*)(WT + (size_t)(dst_row0 + n) * K + k0 + 8 * c) = o;
    }
    asm volatile("s_waitcnt lgkmcnt(0)" ::: "memory");
}
__device__ __forceinline__ void sincos_f(float x, float& s, float& c) {
    const float k = __builtin_rintf(x * 0.63661977236758134308f);
    float r = __builtin_fmaf(-k, 1.5703125f, x); r = __builtin_fmaf(-k, 4.837512969970703125e-4f, r); r = __builtin_fmaf(-k, 7.54978995489188e-8f, r);
    const float r2 = r * r;
    float sp = 2.7557319e-6f; sp = sp * r2 - 1.9841270e-4f; sp = sp * r2 + 8.3333333e-3f; sp = sp * r2 - 1.6666667e-1f; sp = sp * r2 * r + r;
    float cp = 2.4801587e-5f; cp = cp * r2 - 1.3888889e-3f; cp = cp * r2 + 4.1666667e-2f; cp = cp * r2 - 0.5f; cp = cp * r2 + 1.0f;
    const int q = ((int)k) & 3;
    s = (q == 0) ? sp : (q == 1) ? cp : (q == 2) ? -sp : -cp;
    c = (q == 0) ? cp : (q == 1) ? -sp : (q == 2) ? -cp : sp;
}
__device__ __forceinline__ float rope_freq16(int fi) {
    const int a = fi & 3, b = fi >> 2;
    const float f = (a == 0) ? 1.0f : (a == 1) ? 0.56234132519034908f : (a == 2) ? 0.31622776601683794f : 0.17782794100389228f;
    const float g = (b == 0) ? 1.0f : (b == 1) ? 0.1f : (b == 2) ? 0.01f : 0.001f;
    return f * g;
}
struct TDesc { int in_idx, K, N, nb, mode, items; unsigned long long ws_off, dst_bytes; };
__device__ const TDesc TD[7] = {
    {14, 1024, 2816, 88, 1, 8 * 16 * 88, WS_WGU, SZ_WGU1},
    {15, 1024, 2816, 88, 2, 8 * 16 * 88, WS_WGU, SZ_WGU1},
    {16, 2816, 1024, 32, 0, 8 * 44 * 32, WS_WD, SZ_WD1},
    {17, 1024, 2224, 72, 0, 4 * 16 * 72, WS_WIN, SZ_WIN1},
    {26, 1024, 1024, 32, 0, 4 * 16 * 32, WS_WOUT, SZ_WOUT1},
    {23, 256, 576, 24, 0, 4 * 4 * 24, WS_WUQ, SZ_WUQ1},
    {25, 256, 768, 24, 0, 4 * 4 * 24, WS_WUKV, SZ_WUKV1}};
__device__ __forceinline__ void phase_prologue(ArgsP a, LAS unsigned char* lds) {
    const int tid = pg8::lt_tid(), lane = tid & 63, wave = tid >> 6;
    const int G = gridDim.x, gw = blockIdx.x * NWAVES + wave, NGW = G * NWAVES;
    unsigned char* ws = a->ws;
    {
        LAS float* scr = (LAS float*)(lds + wave * 8704);
        int total = 0;
#pragma unroll 1
        for (int d = 0; d < 7; ++d) total += TD[d].items;
#pragma unroll 1
        for (int it = gw; it < total; it += NGW) {
            int d = 0, r = it;
#pragma unroll 1
            while (r >= TD[d].items) { r -= TD[d].items; ++d; }
            const int K = TD[d].K, N = TD[d].N, nb = TD[d].nb, mode = TD[d].mode, per_mat = (K >> 6) * nb;
            const int m = r / per_mat, sub = r % per_mat, kb = sub / nb, n0 = (sub % nb) * 32;
            const float* W = a->in[TD[d].in_idx] + (size_t)m * K * N;
            bf16_t* WT = (bf16_t*)(ws + TD[d].ws_off + (size_t)m * TD[d].dst_bytes);
            const int drow = mode == 0 ? n0 : (n0 >> 7) * 256 + (mode == 2 ? 128 : 0) + (n0 & 127);
            transpose_item(W, K, N, WT, drow, kb * 64, n0, scr, lane);
        }
    }
    __syncthreads();
    {
        LAS float* sc = (LAS float*)lds;
        LAS float* red = (LAS float*)(lds + 12288);
        for (int i = tid; i < 3072; i += NTHREADS) { const int cd = i >> 10, k = i & 1023; const float v = (cd == 0) ? a->in[10][k] : a->in[2][(cd - 1) * 1024 + k]; sc[i] = v / (1.0f + __expf(-v)); }
        __syncthreads();
        float* mods = (float*)(ws + WS_MODS);
        const int kp = tid >> 6, ci = tid & 63;
        for (int it = blockIdx.x; it < NLAYER * 144; it += G) {
            const int l = it / 144, n0 = (it % 144) * 64;
            const float* W = a->in[11] + (size_t)l * DM * 9216 + n0 + ci;
            float a0 = 0.f, a1 = 0.f, a2 = 0.f;
#pragma unroll 8
            for (int k = kp * 128; k < kp * 128 + 128; ++k) { const float w = W[(size_t)k * 9216]; a0 += sc[k] * w; a1 += sc[1024 + k] * w; a2 += sc[2048 + k] * w; }
            red[(kp * 3 + 0) * 64 + ci] = a0; red[(kp * 3 + 1) * 64 + ci] = a1; red[(kp * 3 + 2) * 64 + ci] = a2;
            __syncthreads();
            if (tid < 192) { const int cd = tid >> 6; float s = a->in[12][(size_t)l * 9216 + n0 + ci];
#pragma unroll
                for (int q = 0; q < 8; ++q) s += red[(q * 3 + cd) * 64 + ci];
                mods[((size_t)l * 3 + cd) * 9216 + n0 + ci] = s; }
            __syncthreads();
        }
    }
    {
        f32x4* X = (f32x4*)(ws + WS_X);
        const f32x4* xp = (const f32x4*)a->in[0]; const f32x4* xs = (const f32x4*)a->in[1];
        const size_t half = (size_t)MCTX * DM / 4;
        for (size_t i = (size_t)blockIdx.x * NTHREADS + tid; i < half; i += (size_t)G * NTHREADS) { X[i] = xp[i]; X[half + i] = xs[i]; }
    }
    {
        float* r64 = (float*)(ws + WS_ROPE64); float* r32 = (float*)(ws + WS_ROPE32);
        for (int i = blockIdx.x * NTHREADS + tid; i < 4096 * 32 + 4096 * 16; i += G * NTHREADS) {
            if (i < 4096 * 32) { const int t = i >> 5, j = i & 31; const int pos = (j < 16) ? (t >> 6) : (t & 63); const float ang = (float)pos * rope_freq16(j & 15);
                float s, c; sincos_f(ang, s, c); r64[(size_t)t * 64 + j] = c; r64[(size_t)t * 64 + 32 + j] = s; }
            else { const int ii = i - 4096 * 32; const int t = ii >> 4, j = ii & 15; const int pos = (j < 8) ? (t >> 6) : (t & 63); const float ang = (float)pos * rope_freq16(2 * (j & 7));
                float s, c; sincos_f(ang, s, c); r32[(size_t)t * 32 + j] = c; r32[(size_t)t * 32 + 16 + j] = s; }
        }
    }
}

__device__ __forceinline__ void phase_norm(ArgsP a, int l, int which) {
    const int tid = pg8::lt_tid(), lane = tid & 63, wave = tid >> 6;
    const int gw = blockIdx.x * NWAVES + wave, NGW = gridDim.x * NWAVES;
    const float* X = (const float*)(a->ws + WS_X); bf16_t* XN = (bf16_t*)(a->ws + WS_XN);
    const float* nw = a->in[13] + (size_t)(l * 3 + which) * 1024;
    const float* mods = (const float*)(a->ws + WS_MODS) + (size_t)l * 3 * 9216;
    for (int row = gw; row < M; row += NGW) {
        const int cond = row < MCTX ? 0 : 1 + ((row - MCTX) >> 12);
        const float* sh = mods + cond * 9216 + (3 * which) * 1024; const float* sc = sh + 1024;
        const f32x4* xr = (const f32x4*)(X + (size_t)row * DM) + lane;
        f32x4 v[4]; float s = 0.f;
#pragma unroll
        for (int j = 0; j < 4; ++j) { v[j] = xr[64 * j]; s += (v[j].x * v[j].x + v[j].y * v[j].y) + (v[j].z * v[j].z + v[j].w * v[j].w); }
        const float rstd = 1.0f / sqrtf(wave_sum(s) * (1.0f / DM) + EPS);
        u32x2* o = (u32x2*)(XN + (size_t)row * DM) + lane;
#pragma unroll
        for (int j = 0; j < 4; ++j) {
            const int col = 4 * lane + 256 * j;
            const f32x4 w = *(const f32x4*)(nw + col), cs = *(const f32x4*)(sc + col), hs = *(const f32x4*)(sh + col);
            const f32x4 h = v[j] * rstd * w * (cs + 1.0f) + hs;
            u32x2 p; p.x = cvt_pk_bf16(h.x, h.y); p.y = cvt_pk_bf16(h.z, h.w); o[64 * j] = p;
        }
    }
}
__device__ __forceinline__ void phase_final_norm(ArgsP a) {
    const int tid = pg8::lt_tid(), lane = tid & 63, wave = tid >> 6;
    const int gw = blockIdx.x * NWAVES + wave, NGW = gridDim.x * NWAVES;
    const float* X = (const float*)(a->ws + WS_X); const float* nw = a->in[27];
    for (int row = gw; row < M; row += NGW) {
        const f32x4* xr = (const f32x4*)(X + (size_t)row * DM) + lane;
        f32x4 v[4]; float s = 0.f;
#pragma unroll
        for (int j = 0; j < 4; ++j) { v[j] = xr[64 * j]; s += (v[j].x * v[j].x + v[j].y * v[j].y) + (v[j].z * v[j].z + v[j].w * v[j].w); }
        const float rstd = 1.0f / sqrtf(wave_sum(s) * (1.0f / DM) + EPS);
        f32x4* o = (f32x4*)(a->out + (size_t)row * DM) + lane;
#pragma unroll
        for (int j = 0; j < 4; ++j) o[64 * j] = v[j] * rstd * *(const f32x4*)(nw + 4 * lane + 256 * j);
    }
}

__device__ __forceinline__ void phase_prep(ArgsP a, int l) {
    const int tid = pg8::lt_tid(), lane = tid & 63, wave = tid >> 6;
    const int gw = blockIdx.x * NWAVES + wave, NGW = gridDim.x * NWAVES;
    unsigned char* r1 = a->ws + WS_R1;
    bf16_t* QG = (bf16_t*)(r1 + R1_QG); bf16_t* KG = (bf16_t*)(r1 + R1_KG); bf16_t* VG = (bf16_t*)(r1 + R1_VG);
    bf16_t* QLATN = (bf16_t*)(r1 + R1_QLATN); bf16_t* CKV = (bf16_t*)(r1 + R1_CKV); bf16_t* KROPE = (bf16_t*)(r1 + R1_KROPE);
    const float* PROJ = (const float*)(a->ws + WS_PROJ);
    const float* R64 = (const float*)(a->ws + WS_ROPE64); const float* R32 = (const float*)(a->ws + WS_ROPE32);
    const float* qn = a->in[18] + l * 64; const float* kn = a->in[19] + l * 64;
    const float* mqn = a->in[22] + l * 256; const float* mkvn = a->in[24] + l * 256;
    const float qscale = 0.125f * LOG2E;
    for (int it = gw; it < M + 512; it += NGW) {
        if (it < M) {
            const int row = it; const bool lat = row >= MCTX;
            const int b = lat ? (row - MCTX) >> 12 : row >> 8, t = lat ? (row - MCTX) & 4095 : row & 255;
            const int kvrow = lat ? MCTX + b * 4352 + 256 + t : row;
            const float* pr = PROJ + (size_t)row * NIN;
            const size_t octx = ((size_t)(b * 4 + l) * 256 + t);
            float c64 = 0.f, s64 = 0.f;
            if (lat) { c64 = R64[(size_t)t * 64 + (lane & 31)]; s64 = R64[(size_t)t * 64 + 32 + (lane & 31)]; }
            const float qnw = qn[lane], knw = kn[lane];
#pragma unroll
            for (int h = 0; h < 6; ++h) {
                const float v = pr[C_GQ + 64 * h + lane];
                float y = v * (1.0f / sqrtf(wave_sum(v * v) * (1.0f / 64.0f) + EPS)) * qnw;
                if (lat) { const float p = __shfl_xor(y, 32); y = (lane < 32) ? (y * c64 - p * s64) : (p * s64 + y * c64); }
                QG[(size_t)row * 384 + 64 * h + lane] = bf1(y * qscale);
            }
#pragma unroll
            for (int kvh = 0; kvh < 2; ++kvh) {
                const float v = pr[C_GK + 64 * kvh + lane];
                float y = v * (1.0f / sqrtf(wave_sum(v * v) * (1.0f / 64.0f) + EPS)) * knw;
                if (!lat) a->out[O_GK + octx * 128 + 64 * kvh + lane] = y;
                else { const float p = __shfl_xor(y, 32); y = (lane < 32) ? (y * c64 - p * s64) : (p * s64 + y * c64); }
                KG[(size_t)kvrow * 128 + 64 * kvh + lane] = bf1(y);
                const float vv = pr[C_GV + 64 * kvh + lane];
                if (!lat) a->out[O_GV + octx * 128 + 64 * kvh + lane] = vv;
                VG[(size_t)kvrow * 128 + 64 * kvh + lane] = bf1(vv);
            }
            {
                const f32x4 v = *(const f32x4*)(pr + C_QLAT + 4 * lane);
                const float rstd = 1.0f / sqrtf(wave_sum((v.x * v.x + v.y * v.y) + (v.z * v.z + v.w * v.w)) * (1.0f / 256.0f) + EPS);
                const f32x4 y = v * rstd * *(const f32x4*)(mqn + 4 * lane);
                u32x2 p; p.x = cvt_pk_bf16(y.x, y.y); p.y = cvt_pk_bf16(y.z, y.w); *(u32x2*)(QLATN + (size_t)row * 256 + 4 * lane) = p;
            }
            {
                const f32x4 v = *(const f32x4*)(pr + C_KVLAT + 4 * lane);
                const float rstd = 1.0f / sqrtf(wave_sum((v.x * v.x + v.y * v.y) + (v.z * v.z + v.w * v.w)) * (1.0f / 256.0f) + EPS);
                const f32x4 y = v * rstd * *(const f32x4*)(mkvn + 4 * lane);
                if (!lat) *(f32x4*)(a->out + O_CKV + octx * 256 + 4 * lane) = y;
                u32x2 p; p.x = cvt_pk_bf16(y.x, y.y); p.y = cvt_pk_bf16(y.z, y.w); *(u32x2*)(CKV + (size_t)kvrow * 256 + 4 * lane) = p;
            }
            {
                float v = pr[C_KROPE + (lane & 31)];
                if (!lat) { if (lane < 32) a->out[O_KR + octx * 32 + lane] = v; }
                else { const float c = R32[(size_t)t * 32 + (lane & 15)], s = R32[(size_t)t * 32 + 16 + (lane & 15)]; const float p = __shfl_xor(v, 16); v = (lane & 16) ? (p * s + v * c) : (v * c - p * s); }
                if (lane < 32) KROPE[(size_t)kvrow * 32 + lane] = bf1(v);
            }
        } else {
            const int idx = it - M, b = idx >> 8, s = idx & 255; const int kvrow = MCTX + b * 4352 + s;
            const size_t crow_ = (size_t)(b * 4 + l) * 256 + s;
            const float* ck = a->in[3] + crow_ * 128; const float* cv = a->in[4] + crow_ * 128;
#pragma unroll
            for (int kvh = 0; kvh < 2; ++kvh) {
                KG[(size_t)kvrow * 128 + 64 * kvh + lane] = bf1(ck[64 * kvh + lane]);
                VG[(size_t)kvrow * 128 + 64 * kvh + lane] = bf1(cv[64 * kvh + lane]);
            }
            const f32x4 y = *(const f32x4*)(a->in[5] + crow_ * 256 + 4 * lane);
            u32x2 p; p.x = cvt_pk_bf16(y.x, y.y); p.y = cvt_pk_bf16(y.z, y.w); *(u32x2*)(CKV + (size_t)kvrow * 256 + 4 * lane) = p;
            if (lane < 32) KROPE[(size_t)kvrow * 32 + lane] = bf1(a->in[6][crow_ * 32 + lane]);
        }
    }
    {
        float* LA = (float*)(a->ws + WS_MLA); float* LN = (float*)(a->ws + WS_MLN); float* LS = (float*)(a->ws + WS_MLS);
        const float* gb = a->in[20] + l * 16;
        const int hi = lane >> 5, l31 = lane & 31;
        for (int u = gw; u < 2048; u += NGW) {
            int h, d, c, rowbase;
            if (u < 1024) { const int bb = u >> 5; h = (u >> 3) & 3; d = (u >> 2) & 1; c = u & 3; rowbase = bb * 256; }
            else { const int v = u - 1024; const int b = v >> 9; h = (v >> 7) & 3; d = (v >> 6) & 1; c = v & 63; rowbase = MCTX + b * 4096; }
            const int r0 = rowbase + 64 * c;
            const float* pr = PROJ + (size_t)(r0 + lane) * NIN + C_MG;
            const float li = pr[(2 * d) * 4 + h] + gb[(2 * d) * 4 + h];
            const float lf = log_sigmoid(pr[(2 * d + 1) * 4 + h] + gb[(2 * d + 1) * 4 + h]);
            float bcum;
            if (d == 0) bcum = scan_sum(lf, lane); else { const float rv = __shfl(lf, 63 - lane); bcum = __shfl(scan_sum(rv, lane), 63 - lane); }
            const float bL = __shfl(bcum, d == 0 ? 63 : 0);
            const float decay = bL - bcum + li;
            const float mloc = wave_max(decay);
            const float w = __expf(decay - mloc);
            f32x16 acc[2][2];
#pragma unroll
            for (int i = 0; i < 2; ++i)
#pragma unroll
                for (int j = 0; j < 2; ++j) acc[i][j] = f32x16{};
            float nacc0 = 0.f, nacc1 = 0.f;
            const float* kbase = PROJ + (size_t)r0 * NIN + C_MK + 64 * h + l31;
            const float* vbase = PROJ + (size_t)r0 * NIN + C_MV + 64 * h + l31;
#pragma unroll 4
            for (int j = 0; j < 32; ++j) {
                const int s = 2 * j + hi;
                const float wsv = __shfl(w, s);
                const float k0 = kbase[(size_t)s * NIN] * wsv, k1 = kbase[(size_t)s * NIN + 32] * wsv;
                const float v0 = vbase[(size_t)s * NIN], v1 = vbase[(size_t)s * NIN + 32];
                acc[0][0] = __builtin_amdgcn_mfma_f32_32x32x2f32(k0, v0, acc[0][0], 0, 0, 0);
                acc[0][1] = __builtin_amdgcn_mfma_f32_32x32x2f32(k0, v1, acc[0][1], 0, 0, 0);
                acc[1][0] = __builtin_amdgcn_mfma_f32_32x32x2f32(k1, v0, acc[1][0], 0, 0, 0);
                acc[1][1] = __builtin_amdgcn_mfma_f32_32x32x2f32(k1, v1, acc[1][1], 0, 0, 0);
                nacc0 += k0; nacc1 += k1;
            }
            nacc0 += __shfl_xor(nacc0, 32); nacc1 += __shfl_xor(nacc1, 32);
            float* Au = LA + (size_t)u * 4096;
#pragma unroll
            for (int dkb = 0; dkb < 2; ++dkb)
#pragma unroll
                for (int dvb = 0; dvb < 2; ++dvb)
#pragma unroll
                    for (int r = 0; r < 16; ++r) Au[(32 * dkb + crow(r, hi)) * 64 + 32 * dvb + l31] = acc[dkb][dvb][r];
            if (hi == 0) { LN[(size_t)u * 64 + l31] = nacc0; LN[(size_t)u * 64 + 32 + l31] = nacc1; }
            if (lane == 0) { LS[(size_t)u * 4 + 0] = bL; LS[(size_t)u * 4 + 1] = mloc; }
        }
    }
}

__device__ __forceinline__ void mlstm_scan_chain(ArgsP a, int l, int chain_is_lat, int chain, int e) {
    float* LA = (float*)(a->ws + WS_MLA); float* LN = (float*)(a->ws + WS_MLN); float* LS = (float*)(a->ws + WS_MLS);
    float C, n = 0.f, m; int nc, ubase; const int d = chain & 1, h = (chain >> 1) & 3, bb = chain >> 3;
    if (chain_is_lat) {
        const size_t sidx = ((size_t)(bb * 4 + l) * 2 + d) * 4 + h;
        C = a->in[7][sidx * 4096 + e]; if (e < 64) n = a->in[8][sidx * 64 + e]; m = a->in[9][sidx];
        nc = 64; ubase = 1024 + chain * 64;
    } else { C = 0.f; m = 0.f; nc = 4; ubase = chain * 4; }
#pragma unroll 1
    for (int s0 = 0; s0 < nc; s0 += 4) {
        float bLv[4], mlv[4], av[4], anv[4];
#pragma unroll
        for (int i = 0; i < 4; ++i) {
            const int c = d == 0 ? s0 + i : nc - 1 - (s0 + i); const size_t u = (size_t)(ubase + c);
            bLv[i] = LS[u * 4 + 0]; mlv[i] = LS[u * 4 + 1]; av[i] = LA[u * 4096 + e]; anv[i] = (e < 64) ? LN[u * 64 + e] : 0.f;
        }
#pragma unroll
        for (int i = 0; i < 4; ++i) {
            const int c = d == 0 ? s0 + i : nc - 1 - (s0 + i); const size_t u = (size_t)(ubase + c);
            LA[u * 4096 + e] = C; if (e < 64) LN[u * 64 + e] = n; if (e == 0) LS[u * 4 + 2] = m;
            const float mnew = fmaxf(bLv[i] + m, mlv[i]);
            const float wold = __expf(bLv[i] + m - mnew), wloc = __expf(mlv[i] - mnew);
            C = wold * C + wloc * av[i]; n = wold * n + wloc * anv[i]; m = mnew;
        }
    }
    if (!chain_is_lat) {
        const size_t sidx = ((size_t)(bb * 4 + l) * 2 + d) * 4 + h;
        a->out[O_C + sidx * 4096 + e] = C; if (e < 64) a->out[O_N + sidx * 64 + e] = n; if (e == 0) a->out[O_MM + sidx] = m;
    }
}
__device__ __forceinline__ void phase_mlstm_scan(ArgsP a, int l) {
    int bxl = blockIdx.x; asm volatile("" : "+s"(bxl));
    const int NT = gridDim.x * NTHREADS, gt = bxl * NTHREADS + pg8::lt_tid();
    constexpr int NLAT = 16 * 4096, NCTX = 256 * 4096;
    for (int task = gt; task < NLAT; task += NT) mlstm_scan_chain(a, l, 1, task >> 12, task & 4095);
    if (NT > NLAT) { if (gt >= NLAT) for (int k = gt - NLAT; k < NCTX; k += NT - NLAT) mlstm_scan_chain(a, l, 0, k >> 12, k & 4095); }
    else for (int k = gt; k < NCTX; k += NT) mlstm_scan_chain(a, l, 0, k >> 12, k & 4095);
}

__device__ __forceinline__ void phase_mlstm_out(ArgsP a, int l) {
    const int tid = pg8::lt_tid(), lane = tid & 63, wave = tid >> 6, hi = lane >> 5, l31 = lane & 31;
    const int G = gridDim.x;
    const float* PROJ = (const float*)(a->ws + WS_PROJ);
    const float* LA = (const float*)(a->ws + WS_MLA); const float* LN = (const float*)(a->ws + WS_MLN); const float* LS = (const float*)(a->ws + WS_MLS);
    bf16_t* CAT = (bf16_t*)(a->ws + WS_XN);
    const float* gb = a->in[20] + l * 16; const float* onw = a->in[21] + l * 256;
    for (int item = wave * G + blockIdx.x; item < 2048; item += NWAVES * G) {
        const int u2 = item >> 1, tb = item & 1;
        int h, c, rowbase, ul0, ulstride;
        if (u2 < 512) { const int bb = u2 >> 4; h = (u2 >> 2) & 3; c = u2 & 3; rowbase = bb * 256; ul0 = ((bb * 4 + h) * 2) * 4 + c; ulstride = 4; }
        else { const int v = u2 - 512; const int b = v >> 8; h = (v >> 6) & 3; c = v & 63; rowbase = MCTX + b * 4096; ul0 = 1024 + ((b * 4 + h) * 2) * 64 + c; ulstride = 64; }
        const int r0 = rowbase + 64 * c;
        const float* prg = PROJ + (size_t)(r0 + lane) * NIN + C_MG;
        {
            const int tau = 32 * tb + l31;
            f32x16 hsum[2]; hsum[0] = f32x16{}; hsum[1] = f32x16{};
#pragma unroll 1
            for (int d = 0; d < 2; ++d) {
                const size_t ul = (size_t)(ul0 + d * ulstride);
                const float m_in = LS[ul * 4 + 2];
                const float* Cin = LA + ul * 4096; const float* nin = LN + ul * 64;
                const float li = prg[(2 * d) * 4 + h] + gb[(2 * d) * 4 + h];
                const float lf = log_sigmoid(prg[(2 * d + 1) * 4 + h] + gb[(2 * d + 1) * 4 + h]);
                float bcum, pm;
                if (d == 0) { bcum = scan_sum(lf, lane); pm = scan_max(li - bcum, lane); }
                else { const float rv = __shfl(lf, 63 - lane); bcum = __shfl(scan_sum(rv, lane), 63 - lane); const float ru = __shfl(li - bcum, 63 - lane); pm = __shfl(scan_max(ru, lane), 63 - lane); }
                const float uu = li - bcum;
                const float Mx = fmaxf(m_in, pm);
                const float M_t = __shfl(Mx, tau), b_t = __shfl(bcum, tau);
                const float winter = __expf(m_in - M_t);
                const float* qrow = PROJ + (size_t)(r0 + tau) * NIN + C_MQ + 64 * h + 32 * hi;
                float qn = 0.f;
#pragma unroll 1
                for (int j = 0; j < 8; ++j) { const f32x4 q4 = *(const f32x4*)(qrow + 4 * j), n4 = *(const f32x4*)(nin + 32 * hi + 4 * j); qn += (q4.x * n4.x + q4.y * n4.y) + (q4.z * n4.z + q4.w * n4.w); }
                qn = (qn + __shfl_xor(qn, 32)) * 0.125f;
                f32x16 o[2]; o[0] = f32x16{}; o[1] = f32x16{};
                float densum = 0.f;
                const float qsc = 0.125f * winter;
                {
                    const float* cbase = Cin + (size_t)(32 * hi) * 64 + l31;
#pragma unroll 1
                    for (int j = 0; j < 8; ++j) {
                        const f32x4 q4 = *(const f32x4*)(qrow + 4 * j) * qsc;
                        const float* cp = cbase + (size_t)(4 * j) * 64;
#pragma unroll
                        for (int i = 0; i < 4; ++i) {
                            o[0] = __builtin_amdgcn_mfma_f32_32x32x2f32(cp[i * 64], q4[i], o[0], 0, 0, 0);
                            o[1] = __builtin_amdgcn_mfma_f32_32x32x2f32(cp[i * 64 + 32], q4[i], o[1], 0, 0, 0);
                        }
                    }
                }
#pragma unroll 1
                for (int sb = 0; sb < 2; ++sb) {
                    const bool act = (d == 0) ? (sb <= tb) : (sb >= tb);
                    if (act) {
                        f32x16 p = f32x16{};
                        const float* krow = PROJ + (size_t)(r0 + 32 * sb + l31) * NIN + C_MK + 64 * h + 32 * hi;
#pragma unroll 1
                        for (int j = 0; j < 8; ++j) {
                            const f32x4 k4 = *(const f32x4*)(krow + 4 * j), q4 = *(const f32x4*)(qrow + 4 * j) * 0.125f;
#pragma unroll
                            for (int i = 0; i < 4; ++i) p = __builtin_amdgcn_mfma_f32_32x32x2f32(k4[i], q4[i], p, 0, 0, 0);
                        }
                        const float* vb0 = PROJ + (size_t)(r0 + 32 * sb + 4 * hi) * NIN + C_MV + 64 * h + l31;
#pragma unroll
                        for (int r = 0; r < 16; ++r) {
                            const int s = 32 * sb + crow(r, hi);
                            const float us = __shfl(uu, s);
                            const bool ok = (d == 0) ? (s <= tau) : (s >= tau);
                            const float pv = ok ? p[r] * __expf(us - M_t) : 0.f;
                            densum += pv;
                            const float* vp = vb0 + (size_t)((r & 3) + 8 * (r >> 2)) * NIN;
                            o[0] = __builtin_amdgcn_mfma_f32_32x32x2f32(vp[0], pv, o[0], 0, 0, 0);
                            o[1] = __builtin_amdgcn_mfma_f32_32x32x2f32(vp[32], pv, o[1], 0, 0, 0);
                            if ((r & 3) == 3) __builtin_amdgcn_sched_barrier(0);
                        }
                    }
                }
                densum += __shfl_xor(densum, 32);
                const float den = winter * qn + densum;
                const float dnm = fmaxf(fabsf(den), __expf(-(b_t + M_t)));
                const float inv = 1.0f / dnm;
#pragma unroll
                for (int r = 0; r < 16; ++r) { hsum[0][r] += o[0][r] * inv; hsum[1][r] += o[1][r] * inv; }
            }
            float ss = 0.f;
#pragma unroll
            for (int r = 0; r < 16; ++r) ss += hsum[0][r] * hsum[0][r] + hsum[1][r] * hsum[1][r];
            ss += __shfl_xor(ss, 32);
            const float rstd = 1.0f / sqrtf(ss * (1.0f / 64.0f) + EPS);
            const size_t row = (size_t)(r0 + tau);
            const float* mo = PROJ + row * NIN + C_MO + 64 * h;
#pragma unroll
            for (int dvb = 0; dvb < 2; ++dvb)
#pragma unroll
                for (int g = 0; g < 4; ++g) {
                    const int dv = 32 * dvb + 8 * g + 4 * hi;
                    const f32x4 og = *(const f32x4*)(mo + dv), nw4 = *(const f32x4*)(onw + 64 * h + dv);
                    float y[4];
#pragma unroll
                    for (int i = 0; i < 4; ++i) y[i] = hsum[dvb][4 * g + i] * rstd * nw4[i] * (1.0f / (1.0f + __expf(-og[i])));
                    u32x2 pk; pk.x = cvt_pk_bf16(y[0], y[1]); pk.y = cvt_pk_bf16(y[2], y[3]);
                    *(u32x2*)(CAT + row * 1024 + 384 + 64 * h + dv) = pk;
                }
        }
    }
}

template <int DQK>
__device__ __forceinline__ void attn_unit(const bf16_t* Qb, int qstride, const bf16_t* Kb, int kstride, const bf16_t* Krope, const bf16_t* Vb, int vstride, int S, bf16_t* Ob, LAS unsigned char* lds, const float* rope32, int t0) {
    constexpr int KST = DQK * 2 + 16, VST = 144, KBUF = 64 * KST, VBUF = 64 * VST, NQ = DQK / 16;
    const int tid = pg8::lt_tid(), lane = tid & 63, wave = tid >> 6, hi = lane >> 5, l31 = lane & 31;
    LAS unsigned char* Kl = lds; LAS unsigned char* Vl = lds + 2 * KBUF;
    bf16x8 q[NQ];
    { const bf16_t* qp = Qb + (size_t)(wave * 32 + l31) * qstride + 8 * hi;
#pragma unroll
      for (int i = 0; i < NQ; ++i) q[i] = *(const bf16x8*)(qp + 16 * i); }
    if constexpr (DQK == 96) {
        if (rope32) {
            const float* rp = rope32 + (size_t)(t0 + wave * 32 + l31) * 32 + 8 * hi;
            const f32x4 c0 = *(const f32x4*)(rp), c1 = *(const f32x4*)(rp + 4), s0 = *(const f32x4*)(rp + 16), s1 = *(const f32x4*)(rp + 20);
            float y1[8], y2[8];
#pragma unroll
            for (int e = 0; e < 8; ++e) {
                const float x1 = __uint_as_float(((unsigned)(unsigned short)q[4][e]) << 16), x2 = __uint_as_float(((unsigned)(unsigned short)q[5][e]) << 16);
                const float c = e < 4 ? c0[e & 3] : c1[e & 3], sn = e < 4 ? s0[e & 3] : s1[e & 3];
                y1[e] = x1 * c - x2 * sn; y2[e] = x1 * sn + x2 * c;
            }
            u32x4 w1 = u32x4{cvt_pk_bf16(y1[0], y1[1]), cvt_pk_bf16(y1[2], y1[3]), cvt_pk_bf16(y1[4], y1[5]), cvt_pk_bf16(y1[6], y1[7])};
            u32x4 w2 = u32x4{cvt_pk_bf16(y2[0], y2[1]), cvt_pk_bf16(y2[2], y2[3]), cvt_pk_bf16(y2[4], y2[5]), cvt_pk_bf16(y2[6], y2[7])};
            q[4] = __builtin_bit_cast(bf16x8, w1); q[5] = __builtin_bit_cast(bf16x8, w2);
        }
    }
    const int kkey = tid >> 3, kch = tid & 7, rkey = (tid >> 2) & 63, rch = tid & 3;
    const bf16_t* ksrc = Kb + (size_t)kkey * kstride + kch * 8;
    const bf16_t* rsrc = (DQK == 96) ? Krope + (size_t)rkey * 32 + rch * 8 : nullptr;
    const int vkey = tid & 63, vch = tid >> 6;
    const bf16_t* vsrc = Vb + (size_t)vkey * vstride + vch * 8;
    const int kdst = kkey * KST + kch * 16, rdst = rkey * KST + 128 + rch * 16, vdst = (vch * 8) * VST + vkey * 2;
    u32x4 kreg, rreg = u32x4{}, vreg;
    const int nt = S / 64;
    kreg = *(const u32x4*)ksrc; vreg = *(const u32x4*)vsrc; if (DQK == 96 && tid < 256) rreg = *(const u32x4*)rsrc;
    __syncthreads();
    *(LAS u32x4*)(Kl + kdst) = kreg; if (DQK == 96 && tid < 256) *(LAS u32x4*)(Kl + rdst) = rreg;
#define VT_STORE(buf) do { LAS unsigned short* vp_ = (LAS unsigned short*)(Vl + (buf) * VBUF + vdst); \
        vp_[0] = (unsigned short)(vreg.x & 0xffffu); vp_[VST / 2] = (unsigned short)(vreg.x >> 16); vp_[2 * (VST / 2)] = (unsigned short)(vreg.y & 0xffffu); vp_[3 * (VST / 2)] = (unsigned short)(vreg.y >> 16); \
        vp_[4 * (VST / 2)] = (unsigned short)(vreg.z & 0xffffu); vp_[5 * (VST / 2)] = (unsigned short)(vreg.z >> 16); vp_[6 * (VST / 2)] = (unsigned short)(vreg.w & 0xffffu); vp_[7 * (VST / 2)] = (unsigned short)(vreg.w >> 16); } while (0)
    VT_STORE(0);
    __syncthreads();
    float mrun = -INFINITY, lsum = 0.f;
    f32x16 o[2]; o[0] = f32x16{}; o[1] = f32x16{};
    for (int t = 0; t < nt; ++t) {
        const int cur = t & 1;
        if (t + 1 < nt) {
            kreg = *(const u32x4*)(ksrc + (size_t)(t + 1) * 64 * kstride); vreg = *(const u32x4*)(vsrc + (size_t)(t + 1) * 64 * vstride);
            if (DQK == 96 && tid < 256) rreg = *(const u32x4*)(rsrc + (size_t)(t + 1) * 64 * 32);
        }
        __builtin_amdgcn_sched_barrier(0);
        const LAS unsigned char* kb = Kl + cur * KBUF + l31 * KST + hi * 16;
        f32x16 p0 = f32x16{}, p1 = f32x16{};
#pragma unroll
        for (int i = 0; i < NQ; ++i) {
            const bf16x8 k0 = *(const LAS bf16x8*)(kb + i * 32), k1 = *(const LAS bf16x8*)(kb + 32 * KST + i * 32);
            p0 = __builtin_amdgcn_mfma_f32_32x32x16_bf16(k0, q[i], p0, 0, 0, 0);
            p1 = __builtin_amdgcn_mfma_f32_32x32x16_bf16(k1, q[i], p1, 0, 0, 0);
            if (i == 2) __builtin_amdgcn_sched_barrier(0);
        }
        __builtin_amdgcn_sched_barrier(0);
        float mx = fmaxf(p0[0], p1[0]);
#pragma unroll
        for (int r = 1; r < 16; ++r) mx = fmaxf(mx, fmaxf(p0[r], p1[r]));
        mx = fmaxf(mx, __shfl_xor(mx, 32));
        const float mnew = fmaxf(mrun, mx);
        const float alpha = __builtin_amdgcn_exp2f(mrun - mnew);
        mrun = mnew;
        float ps = 0.f;
#pragma unroll
        for (int r = 0; r < 16; ++r) { p0[r] = __builtin_amdgcn_exp2f(p0[r] - mnew); p1[r] = __builtin_amdgcn_exp2f(p1[r] - mnew); ps += p0[r] + p1[r]; }
        lsum = lsum * alpha + ps;
#pragma unroll
        for (int r = 0; r < 16; ++r) { o[0][r] *= alpha; o[1][r] *= alpha; }
        u32x4 pw[4];
        pw[0] = u32x4{cvt_pk_bf16(p0[0], p0[1]), cvt_pk_bf16(p0[2], p0[3]), cvt_pk_bf16(p0[4], p0[5]), cvt_pk_bf16(p0[6], p0[7])};
        pw[1] = u32x4{cvt_pk_bf16(p0[8], p0[9]), cvt_pk_bf16(p0[10], p0[11]), cvt_pk_bf16(p0[12], p0[13]), cvt_pk_bf16(p0[14], p0[15])};
        pw[2] = u32x4{cvt_pk_bf16(p1[0], p1[1]), cvt_pk_bf16(p1[2], p1[3]), cvt_pk_bf16(p1[4], p1[5]), cvt_pk_bf16(p1[6], p1[7])};
        pw[3] = u32x4{cvt_pk_bf16(p1[8], p1[9]), cvt_pk_bf16(p1[10], p1[11]), cvt_pk_bf16(p1[12], p1[13]), cvt_pk_bf16(p1[14], p1[15])};
        __builtin_amdgcn_sched_barrier(0);
        const LAS unsigned char* vb = Vl + cur * VBUF + l31 * VST + hi * 8;
#pragma unroll
        for (int db = 0; db < 2; ++db)
#pragma unroll
            for (int ks = 0; ks < 4; ++ks) {
                const s16x4 lo = *(const LAS s16x4*)(vb + db * 32 * VST + ks * 32), hi4 = *(const LAS s16x4*)(vb + db * 32 * VST + ks * 32 + 16);
                const bf16x8 vf = (bf16x8){lo[0], lo[1], lo[2], lo[3], hi4[0], hi4[1], hi4[2], hi4[3]};
                o[db] = __builtin_amdgcn_mfma_f32_32x32x16_bf16(vf, __builtin_bit_cast(bf16x8, pw[ks]), o[db], 0, 0, 0);
                if (ks == 3) __builtin_amdgcn_sched_barrier(0);
            }
        __builtin_amdgcn_sched_barrier(0);
        if (t + 1 < nt) {
            const int nx = cur ^ 1;
            *(LAS u32x4*)(Kl + nx * KBUF + kdst) = kreg; VT_STORE(nx); if (DQK == 96 && tid < 256) *(LAS u32x4*)(Kl + nx * KBUF + rdst) = rreg;
        }
        __syncthreads();
    }
    lsum += __shfl_xor(lsum, 32);
    const float inv = 1.0f / lsum;
    bf16_t* op = Ob + (size_t)(wave * 32 + l31) * 1024;
#pragma unroll
    for (int db = 0; db < 2; ++db)
#pragma unroll
        for (int g = 0; g < 4; ++g) {
            u32x2 pk; pk.x = cvt_pk_bf16(o[db][4 * g] * inv, o[db][4 * g + 1] * inv); pk.y = cvt_pk_bf16(o[db][4 * g + 2] * inv, o[db][4 * g + 3] * inv);
            *(u32x2*)(op + 32 * db + 8 * g + 4 * hi) = pk;
        }
#undef VT_STORE
}
__device__ __forceinline__ void phase_attention(ArgsP a, LAS unsigned char* lds) {
    unsigned char* r1 = a->ws + WS_R1;
    const bf16_t* QG = (const bf16_t*)(r1 + R1_QG); const bf16_t* KG = (const bf16_t*)(r1 + R1_KG); const bf16_t* VG = (const bf16_t*)(r1 + R1_VG);
    const bf16_t* KROPE = (const bf16_t*)(r1 + R1_KROPE); const bf16_t* QM = (const bf16_t*)(r1 + R1_QM); const bf16_t* KVM = (const bf16_t*)(r1 + R1_KVM);
    bf16_t* CAT = (bf16_t*)(a->ws + WS_XN);
    for (int ui = blockIdx.x; ui < 768; ui += gridDim.x) {
        const int kind = ui / 192, v = ui % 192;
        if (kind == 0) {
            const int b = v / 96, h = (v / 16) % 6, qb = v & 15; const size_t row0 = MCTX + (size_t)b * 4096 + qb * 256, kv0 = MCTX + (size_t)b * 4352;
            attn_unit<96>(QM + row0 * 768 + h * 96, 768, KVM + kv0 * 768 + h * 128, 768, KROPE + kv0 * 32, KVM + kv0 * 768 + h * 128 + 64, 768, 4352, CAT + row0 * 1024 + 640 + h * 64, lds, (const float*)(a->ws + WS_ROPE32), qb * 256);
        } else if (kind == 1) {
            const int b = v / 96, kvh = (v / 48) & 1, g = (v / 16) % 3, qb = v & 15, hq = kvh * 3 + g; const size_t row0 = MCTX + (size_t)b * 4096 + qb * 256, kv0 = MCTX + (size_t)b * 4352;
            attn_unit<64>(QG + row0 * 384 + hq * 64, 384, KG + kv0 * 128 + kvh * 64, 128, nullptr, VG + kv0 * 128 + kvh * 64, 128, 4352, CAT + row0 * 1024 + hq * 64, lds, nullptr, 0);
        } else if (kind == 2) {
            const int b = v / 6, h = v % 6; const size_t row0 = (size_t)b * 256;
            attn_unit<96>(QM + row0 * 768 + h * 96, 768, KVM + row0 * 768 + h * 128, 768, KROPE + row0 * 32, KVM + row0 * 768 + h * 128 + 64, 768, 256, CAT + row0 * 1024 + 640 + h * 64, lds, nullptr, 0);
        } else {
            const int b = v / 6, hq = v % 6, kvh = hq / 3; const size_t row0 = (size_t)b * 256;
            attn_unit<64>(QG + row0 * 384 + hq * 64, 384, KG + row0 * 128 + kvh * 64, 128, nullptr, VG + row0 * 128 + kvh * 64, 128, 256, CAT + row0 * 1024 + hq * 64, lds, nullptr, 0);
        }
    }
}

__global__ void __launch_bounds__(NTHREADS, 2) mk_fwd(Args a_in) {
    extern __shared__ __attribute__((aligned(16))) unsigned char lds_raw[];
    LAS unsigned char* lds = (LAS unsigned char*)lds_raw;
    cg::grid_group grid = cg::this_grid();
    const int G = gridDim.x;
    for (int ph = a_in.ph_lo; ph < a_in.ph_hi; ++ph) {
        ArgsP a = (ArgsP)__builtin_amdgcn_kernarg_segment_ptr(); asm volatile("" : "+s"(a));
        unsigned char* ws = a->ws;
        int bx = blockIdx.x; asm volatile("" : "+s"(bx));
        const int spid = (ph == 0) ? 12 : (ph == 49) ? 14 : (ph - 1) % 12;
        const int nrep = ((DUPM >> spid) & 1) ? 2 : 1;
#pragma unroll 1
        for (int rep = 0; rep < nrep; ++rep) {
        if (ph == 0) { if (PHM & 1) phase_prologue(a, lds); }
        else if (ph == 49) { if (PHM & 2) phase_final_norm(a); }
        else {
            const int l = (ph - 1) / 12, sp = (ph - 1) % 12;
            const float* mods = (const float*)(ws + WS_MODS) + (size_t)l * 3 * 9216;
            if (sp == 0 || sp == 3 || sp == 9) { if (PHM & 2) phase_norm(a, l, sp == 0 ? 0 : sp == 3 ? 1 : 2); }
            else if ((PHM & 4) && (sp == 1 || sp == 10)) {
                const int j = sp == 1 ? 0 : 1;
                pg8::Gemm g{(const bf16_t*)(ws + WS_XN), (const bf16_t*)(ws + WS_WGU + (size_t)(l * 2 + j) * SZ_WGU1), M, NGU, DM};
                pg8::StaticOrder S; S.init(M, NGU, G, bx);
                pg8::EpiSwiGLU E{(bf16_t*)(ws + WS_R1)};
                pg8::gemm_phase<pg8::EpiSwiGLU, pg8::StaticOrder, true, true>(lds, g, S, E);
            } else if ((PHM & 8) && (sp == 2 || sp == 11)) {
                const int j = sp == 2 ? 0 : 1;
                pg8::Gemm g{(const bf16_t*)(ws + WS_R1), (const bf16_t*)(ws + WS_WD + (size_t)(l * 2 + j) * SZ_WD1), M, DM, FF};
                pg8::StaticOrder S; S.init(M, DM, G, bx);
                pg8::EpiResid E{(const float*)(ws + WS_X), (float*)(ws + WS_X), mods + (j == 0 ? 2 : 8) * 1024, 0.5f};
                pg8::gemm_phase<pg8::EpiResid, pg8::StaticOrder, true, true>(lds, g, S, E);
            } else if ((PHM & 16) && sp == 4) {
                pg8::Gemm g{(const bf16_t*)(ws + WS_XN), (const bf16_t*)(ws + WS_WIN + (size_t)l * SZ_WIN1), M, NIN, DM};
                pg8::StaticOrder S; S.init(M, NIN, G, bx);
                pg8::EpiF32 E{(float*)(ws + WS_PROJ), NIN};
                pg8::gemm_phase<pg8::EpiF32, pg8::StaticOrder, true, true>(lds, g, S, E);
            } else if (sp == 5) { if (PHM & 32) phase_prep(a, l); }
            else if (sp == 6) {
                int k256 = 256; asm volatile("" : "+s"(k256));
                if (PHM & 64) {
                    pg8::Gemm g{(const bf16_t*)(ws + WS_R1 + R1_QLATN), (const bf16_t*)(ws + WS_WUQ + (size_t)l * SZ_WUQ1), M, 768, k256};
                    pg8::StaticOrder S; S.init(M, 768, G, bx);
                    pg8::EpiBf16S E{(bf16_t*)(ws + WS_R1 + R1_QM), 768, 0.10206207261596575f * LOG2E};
                    pg8::gemm_phase<pg8::EpiBf16S, pg8::StaticOrder, true, true>(lds, g, S, E);
                }
                if (PHM & 128) {
                    pg8::Gemm g{(const bf16_t*)(ws + WS_R1 + R1_CKV), (const bf16_t*)(ws + WS_WUKV + (size_t)l * SZ_WUKV1), KVROWS, 768, k256};
                    pg8::StaticOrder S; S.init(KVROWS, 768, G, bx);
                    pg8::EpiBf16S E{(bf16_t*)(ws + WS_R1 + R1_KVM), 768, 1.0f};
                    pg8::gemm_phase<pg8::EpiBf16S, pg8::StaticOrder, true, true>(lds, g, S, E);
                }
                if ((PHM & 256) && rep == 0) phase_mlstm_scan(a, l);
            } else if (sp == 7) { if ((PHM & 512) && (rep == 0 || !(DUPM & 8192))) phase_mlstm_out(a, l); if ((PHM & 1024) && (rep == 0 || (DUPM & 8192))) phase_attention(a, lds); }
            else if ((PHM & 2048) && sp == 8) {
                pg8::Gemm g{(const bf16_t*)(ws + WS_XN), (const bf16_t*)(ws + WS_WOUT + (size_t)l * SZ_WOUT1), M, DM, DM};
                pg8::StaticOrder S; S.init(M, DM, G, bx);
                pg8::EpiResid E{(const float*)(ws + WS_X), (float*)(ws + WS_X), mods + 5 * 1024, 1.0f};
                pg8::gemm_phase<pg8::EpiResid, pg8::StaticOrder, true, true>(lds, g, S, E);
            }
        }
        }
        if (ph + 1 < a_in.ph_hi) grid.sync();
#if defined(MK_XSYNC)
        for (int xs = 0; xs < MK_XSYNC; ++xs) grid.sync();
#endif
    }
}

extern "C" void kernel_launch(void* const* d_in, const int* in_sizes, int n_in, void* d_out, int out_size, void* d_ws, size_t ws_size, hipStream_t stream) {
    static int grid = 0;
    if (grid == 0) {
        if (n_in != 28 || ws_size < WS_END) { fprintf(stderr, "kernel_launch: unexpected n_in %d or ws_size %zu (< %zu)\n", n_in, ws_size, (size_t)WS_END); grid = -1; return; }
        int dev = 0, cus = 0, per_cu = 0;
        hipGetDevice(&dev); hipDeviceGetAttribute(&cus, hipDeviceAttributeMultiprocessorCount, dev);
        hipFuncSetAttribute((const void*)mk_fwd, hipFuncAttributeMaxDynamicSharedMemorySize, LDS_BYTES);
        hipOccupancyMaxActiveBlocksPerMultiprocessor(&per_cu, (const void*)mk_fwd, NTHREADS, LDS_BYTES);
        (void)hipGetLastError();
        if (per_cu < 1) per_cu = 1;
        grid = cus;
        if (grid <= 0) grid = 256;
    }
    if (grid < 0) return;
    Args a{};
    for (int i = 0; i < 28; ++i) a.in[i] = (const float*)d_in[i];
    a.out = (float*)d_out; a.ws = (unsigned char*)d_ws;
#if MK_MULTI_LAUNCH
    for (int ph = 0; ph < 50; ++ph) { a.ph_lo = ph; a.ph_hi = ph + 1; hipLaunchKernelGGL(mk_fwd, dim3(grid), dim3(NTHREADS), LDS_BYTES, stream, a); }
#else
    a.ph_lo = 0; a.ph_hi = 50;
    void* args[] = {&a};
    hipError_t e = hipLaunchCooperativeKernel((const void*)mk_fwd, dim3(grid), dim3(NTHREADS), args, LDS_BYTES, stream);
    if (e != hipSuccess) fprintf(stderr, "cooperative launch failed: %s (grid %d)\n", hipGetErrorString(e), grid);
#endif
}
```

```cpp
#include <hip/hip_runtime.h>
#include <hip/hip_cooperative_groups.h>
#include <cstdio>
#include <cstdint>
namespace cg = cooperative_groups;

#ifndef MK_MULTI_LAUNCH
#define MK_MULTI_LAUNCH 0
#endif
namespace pg8 {
#define PG8_LAS __attribute__((address_space(3)))
__device__ __forceinline__ int lt_tid() { int t = threadIdx.x; asm volatile("" : "+v"(t)); return t; }
typedef unsigned short bf16_t;
typedef short bf16x8 __attribute__((ext_vector_type(8)));
typedef float f32x4 __attribute__((ext_vector_type(4)));
typedef unsigned u32x4 __attribute__((ext_vector_type(4)));
constexpr int BM = 256, BK = 64, HALF = 128, HTB = HALF * BK * 2  , STAGE_BYTES = 8 * HTB, NXCD = 8, WGM = 8;

__host__ __device__ __forceinline__ int lds_byte(int r, int c) { const int st = (r >> 4) * 2 + (c >> 5), rr = r & 15, cc = c & 31, ob = rr * 64 + cc * 2; return st * 1024 + (ob ^ (((ob >> 9) & 1) << 5)); }
__host__ __device__ __forceinline__ void stage_rc(int b, int& R, int& C) { const int st = b / 1024, sb = b % 1024, swz = sb ^ (((sb >> 9) & 1) << 5); R = (st >> 1) * 16 + swz / 64; C = (st & 1) * 32 + (swz % 64) / 2; }
__host__ __device__ __forceinline__ int perm32(int rho) { const int n = rho >> 4, i = rho & 15; return 8 * (i >> 2) + 4 * n + (i & 3); }

struct Unit { int pm, pn; };
struct Gemm { const bf16_t* A; const bf16_t* Bt; int M, N, K; };

struct StaticOrder {
    int nM, nN, nwg, G, c;
    __host__ __device__ void init(int M, int N, int G_, int c_) { nM = M / BM; nN = N / BM; nwg = nM * nN; G = G_; c = c_; }
    __host__ __device__ bool next(int i, Unit& u) const {
        const long L = (long)i * G + c; if (L >= nwg) return false;
        int wgid = (int)L; { const int q = nwg / NXCD, r = nwg % NXCD, xcd = wgid % NXCD, off = wgid / NXCD; wgid = (xcd < r ? xcd * (q + 1) : r * (q + 1) + (xcd - r) * q) + off; }
        const int nig = WGM * nN, gid = wgid / nig, fm = gid * WGM, gsz = (nM - fm) < WGM ? (nM - fm) : WGM;
        u.pm = fm + ((wgid % nig) % gsz); u.pn = (wgid % nig) / gsz; return true;
    }
    __device__ __forceinline__ void a_ready(const Unit&) const {}
    __device__ __forceinline__ void done(const Unit&) const {}
};

__device__ __forceinline__ unsigned cvt_pk_bf16(float lo, float hi) { unsigned r; asm volatile("v_cvt_pk_bf16_f32 %0, %1, %2" : "=v"(r) : "v"(lo), "v"(hi)); return r; }
typedef float f32x2 __attribute__((ext_vector_type(2)));
typedef unsigned u32x2 __attribute__((ext_vector_type(2)));
__device__ __forceinline__ float silu_f(float x) { return x * __builtin_amdgcn_rcpf(1.0f + __expf(-x)); }

struct EpiSwiGLU {
    static constexpr bool PERM = true, AFTER_DRAIN = false;
    bf16_t* O;
    __device__ __forceinline__ void operator()(const f32x4 (&acc)[2][2][4][2], const Unit& u, int wr, int wc, int fr, int fq) const {
        const int row0 = u.pm * BM + wr * 64 + fr, col0 = u.pn * 128 + wc * 32 + 8 * fq;
#pragma unroll
        for (int ai = 0; ai < 2; ++ai)
#pragma unroll
            for (int m = 0; m < 4; ++m) {
                bf16_t* rowp = O + (size_t)(row0 + ai * HALF + m * 16) * 2816 + col0;
                const f32x4 g0 = acc[ai][0][m][0], g1 = acc[ai][0][m][1], u0 = acc[ai][1][m][0], u1 = acc[ai][1][m][1];
                u32x4 w;
                w.x = cvt_pk_bf16(silu_f(g0[0]) * u0[0], silu_f(g0[1]) * u0[1]); w.y = cvt_pk_bf16(silu_f(g0[2]) * u0[2], silu_f(g0[3]) * u0[3]);
                w.z = cvt_pk_bf16(silu_f(g1[0]) * u1[0], silu_f(g1[1]) * u1[1]); w.w = cvt_pk_bf16(silu_f(g1[2]) * u1[2], silu_f(g1[3]) * u1[3]);
                *(u32x4*)rowp = w;
            }
    }
};
struct EpiResid {
    static constexpr bool PERM = false, AFTER_DRAIN = false;
    const float* base; float* out; const float* gmod; float gs;
    __device__ __forceinline__ void operator()(const f32x4 (&acc)[2][2][4][2], const Unit& u, int wr, int wc, int fr, int fq) const {
        const int row0 = u.pm * BM + wr * 64 + fr, col0 = u.pn * BM + wc * 32 + 4 * fq;
        const int cond = u.pm < 32 ? 0 : 1 + ((u.pm - 32) >> 4);
        const float* g = gmod + cond * 9216;
#pragma unroll
        for (int bj = 0; bj < 2; ++bj)
#pragma unroll
            for (int n = 0; n < 2; ++n) {
                const f32x4 gv = *(const f32x4*)(g + col0 + bj * HALF + n * 16) * gs;
#pragma unroll
                for (int ai = 0; ai < 2; ++ai)
#pragma unroll
                    for (int m = 0; m < 4; ++m) {
                        const size_t off = (size_t)(row0 + ai * HALF + m * 16) * 1024 + col0 + bj * HALF + n * 16;
                        *(f32x4*)(out + off) = *(const f32x4*)(base + off) + gv * acc[ai][bj][m][n];
                    }
            }
    }
};
struct EpiF32 {
    static constexpr bool PERM = false, AFTER_DRAIN = false;
    float* out; int ldc;
    __device__ __forceinline__ void operator()(const f32x4 (&acc)[2][2][4][2], const Unit& u, int wr, int wc, int fr, int fq) const {
        const int row0 = u.pm * BM + wr * 64 + fr, col0 = u.pn * BM + wc * 32 + 4 * fq;
#pragma unroll
        for (int ai = 0; ai < 2; ++ai)
#pragma unroll
            for (int m = 0; m < 4; ++m)
#pragma unroll
                for (int bj = 0; bj < 2; ++bj)
#pragma unroll
                    for (int n = 0; n < 2; ++n)
                        *(f32x4*)(out + (size_t)(row0 + ai * HALF + m * 16) * ldc + col0 + bj * HALF + n * 16) = acc[ai][bj][m][n];
    }
};
struct EpiBf16S {
    static constexpr bool PERM = true, AFTER_DRAIN = false;
    bf16_t* O; int ldc; float scale;
    __device__ __forceinline__ void operator()(const f32x4 (&acc)[2][2][4][2], const Unit& u, int wr, int wc, int fr, int fq) const {
        const int row0 = u.pm * BM + wr * 64 + fr, col0 = u.pn * BM + wc * 32 + 8 * fq;
#pragma unroll
        for (int ai = 0; ai < 2; ++ai)
#pragma unroll
            for (int m = 0; m < 4; ++m) {
                bf16_t* rowp = O + (size_t)(row0 + ai * HALF + m * 16) * ldc + col0;
#pragma unroll
                for (int bj = 0; bj < 2; ++bj) {
                    const f32x4 v0 = acc[ai][bj][m][0] * scale, v1 = acc[ai][bj][m][1] * scale;
                    u32x4 w; w.x = cvt_pk_bf16(v0[0], v0[1]); w.y = cvt_pk_bf16(v0[2], v0[3]); w.z = cvt_pk_bf16(v1[0], v1[1]); w.w = cvt_pk_bf16(v1[2], v1[3]);
                    *(u32x4*)(rowp + bj * HALF) = w;
                }
            }
    }
};
template <class Epi, class Sched, bool ALIGN_EPI = false, bool SP2 = false>
__device__ __forceinline__ void gemm_phase(PG8_LAS unsigned char* lds, const Gemm g, const Sched& S, const Epi& E) {
    const int tid = lt_tid(), wid = __builtin_amdgcn_readfirstlane(tid >> 6), lane = tid & 63, wr = wid >> 2, wc = wid & 3, fr = lane & 15, fq = lane >> 4;
    const int K = g.K, nt = K / BK;
    unsigned voffA[2], voffB[2];
#pragma unroll
    for (int i = 0; i < 2; ++i) { int R, C; stage_rc(tid * 16 + i * 8192, R, C); const int Rb = Epi::PERM ? ((R & ~31) + perm32(R & 31)) : R;
        voffA[i] = (unsigned)(R * K + C) * 2u; voffB[i] = (unsigned)(Rb * K + C) * 2u; }
    const size_t kstep = (size_t)(BK * 2);
    const size_t hstep = (size_t)HALF * K * 2;
    const size_t tstep = 2 * hstep;
    const unsigned ldsw = (unsigned)wid * 1024u;
    const int aoff = lds_byte(wr * 64 + fr, fq * 8), boff = lds_byte(wc * 32 + fr, fq * 8);
#define PG8_SA(b, h) (((b) * 2 + (h)) * HTB)
#define PG8_SB(b, h) ((4 + (b) * 2 + (h)) * HTB)
#define PG8_STAGE(bufoff, gbase, voff) do { _Pragma("unroll") for (int _i = 0; _i < 2; ++_i) \
        __builtin_amdgcn_global_load_lds((const unsigned*)((const char*)(gbase) + (voff)[_i]), (PG8_LAS unsigned*)(lds + (bufoff) + ldsw + _i * 8192), 16, 0, 0); } while (0)
#define PG8_LDA(dst, b, h) do { _Pragma("unroll") for (int m = 0; m < 4; ++m) _Pragma("unroll") for (int k = 0; k < 2; ++k) dst[m][k] = *(const PG8_LAS bf16x8*)(lds + PG8_SA(b, h) + aoff + m * 2048 + k * 1024); } while (0)
#define PG8_LDB(dst, b, h) do { _Pragma("unroll") for (int n = 0; n < 2; ++n) _Pragma("unroll") for (int k = 0; k < 2; ++k) dst[n][k] = *(const PG8_LAS bf16x8*)(lds + PG8_SB(b, h) + boff + n * 2048 + k * 1024); } while (0)
#define PG8_MMA(ai, bj, At, Bt) do { __builtin_amdgcn_s_setprio(1); _Pragma("unroll") for (int m = 0; m < 4; ++m) _Pragma("unroll") for (int n = 0; n < 2; ++n) _Pragma("unroll") for (int k = 0; k < 2; ++k) \
        acc[ai][bj][m][n] = __builtin_amdgcn_mfma_f32_16x16x32_bf16(Bt[n][k], At[m][k], acc[ai][bj][m][n], 0, 0, 0); __builtin_amdgcn_s_setprio(0); } while (0)
#define PG8_WAIT_V(n) asm volatile("s_waitcnt vmcnt(" #n ")" ::: "memory")
#define PG8_WAIT_L(n) asm volatile("s_waitcnt lgkmcnt(" #n ")" ::: "memory")
#define PG8_BAR __builtin_amdgcn_s_barrier()
#define PG8_SCHED __builtin_amdgcn_sched_barrier(0)
    Unit cur, nxt; int ui = 0;
    if (!S.next(0, cur)) return;
    f32x4 acc[2][2][4][2];
#pragma unroll
    for (int a = 0; a < 2; ++a)
#pragma unroll
        for (int b = 0; b < 2; ++b)
#pragma unroll
            for (int m = 0; m < 4; ++m)
#pragma unroll
                for (int n = 0; n < 2; ++n) acc[a][b][m][n] = (f32x4){0.f, 0.f, 0.f, 0.f};
    bf16x8 At[4][2], B0[2][2], B1[2][2];
    const char* cA = (const char*)g.A + (size_t)cur.pm * tstep; const char* cB = (const char*)g.Bt + (size_t)cur.pn * tstep;
    S.a_ready(cur);
    if constexpr (SP2) {
        PG8_STAGE(PG8_SB(0, 0), cB, voffB); PG8_STAGE(PG8_SB(0, 1), cB + hstep, voffB); PG8_STAGE(PG8_SA(0, 0), cA, voffA); PG8_STAGE(PG8_SA(0, 1), cA + hstep, voffA);
        if (wr == 1) PG8_BAR;
        PG8_WAIT_V(2); PG8_BAR;
        PG8_STAGE(PG8_SB(1, 0), cB + kstep, voffB); PG8_STAGE(PG8_SA(1, 0), cA + kstep, voffA); PG8_STAGE(PG8_SB(1, 1), cB + hstep + kstep, voffB);
        PG8_WAIT_V(6); PG8_BAR;
    } else {
        PG8_STAGE(PG8_SB(0, 0), cB, voffB); PG8_STAGE(PG8_SA(0, 0), cA, voffA); PG8_STAGE(PG8_SB(0, 1), cB + hstep, voffB); PG8_STAGE(PG8_SA(0, 1), cA + hstep, voffA);
        if (wr == 1) PG8_BAR;
        PG8_WAIT_V(4); PG8_BAR;
        PG8_STAGE(PG8_SB(1, 0), cB + kstep, voffB); PG8_STAGE(PG8_SA(1, 0), cA + kstep, voffA); PG8_STAGE(PG8_SB(1, 1), cB + hstep + kstep, voffB);
        PG8_WAIT_V(6); PG8_BAR;
    }
    for (;;) {
        const bool has_next = S.next(ui + 1, nxt);
        const char* nA = has_next ? (const char*)g.A + (size_t)nxt.pm * tstep : cA; const char* nB = has_next ? (const char*)g.Bt + (size_t)nxt.pn * tstep : cB;
        for (int t = 0; t < nt; t += 2) {
            const bool last = (t == nt - 2);
            const char* a1 = cA + (size_t)(t + 1) * kstep;
            const char* a2 = last ? nA : cA + (size_t)(t + 2) * kstep; const char* b2 = last ? nB : cB + (size_t)(t + 2) * kstep;
            const char* a3 = a2 + kstep; const char* b3 = b2 + kstep;
            if (last && has_next) S.a_ready(nxt);
            if constexpr (SP2) {
            PG8_LDB(B0, 0, 0); PG8_LDB(B1, 0, 1); PG8_SCHED; PG8_LDA(At, 0, 0); PG8_STAGE(PG8_SA(1, 1), a1 + hstep, voffA);
            PG8_WAIT_V(8); PG8_WAIT_L(0); PG8_BAR; PG8_MMA(0, 0, At, B0); PG8_MMA(0, 1, At, B1); PG8_BAR; PG8_SCHED;
            PG8_LDA(At, 0, 1); PG8_STAGE(PG8_SB(0, 0), b2, voffB); PG8_STAGE(PG8_SB(0, 1), b2 + hstep, voffB); PG8_STAGE(PG8_SA(0, 0), a2, voffA);
            PG8_WAIT_V(8); PG8_WAIT_L(0); PG8_BAR; PG8_MMA(1, 0, At, B0); PG8_MMA(1, 1, At, B1); PG8_BAR; PG8_SCHED;
            PG8_LDB(B0, 1, 0); PG8_LDB(B1, 1, 1); PG8_SCHED; PG8_LDA(At, 1, 0); PG8_STAGE(PG8_SA(0, 1), a2 + hstep, voffA);
            PG8_WAIT_V(8); PG8_WAIT_L(0); PG8_BAR; PG8_MMA(0, 0, At, B0); PG8_MMA(0, 1, At, B1); PG8_BAR; PG8_SCHED;
            PG8_LDA(At, 1, 1); PG8_STAGE(PG8_SB(1, 0), b3, voffB); PG8_STAGE(PG8_SB(1, 1), b3 + hstep, voffB); PG8_STAGE(PG8_SA(1, 0), a3, voffA);
            PG8_WAIT_V(8); PG8_WAIT_L(0); PG8_BAR; PG8_MMA(1, 0, At, B0); PG8_MMA(1, 1, At, B1); PG8_BAR; PG8_SCHED;
            } else {
            PG8_LDB(B0, 0, 0); PG8_SCHED; PG8_LDA(At, 0, 0); PG8_STAGE(PG8_SA(1, 1), a1 + hstep, voffA);
            PG8_WAIT_L(8); PG8_BAR; PG8_WAIT_L(0); PG8_MMA(0, 0, At, B0); PG8_BAR; PG8_SCHED;
            PG8_LDB(B1, 0, 1); PG8_STAGE(PG8_SB(0, 0), b2, voffB);
            PG8_BAR; PG8_WAIT_L(0); PG8_MMA(0, 1, At, B1); PG8_BAR;
            PG8_LDA(At, 0, 1); PG8_STAGE(PG8_SA(0, 0), a2, voffA);
            PG8_BAR; PG8_WAIT_L(0); PG8_MMA(1, 0, At, B0); PG8_BAR; PG8_SCHED;
            PG8_STAGE(PG8_SB(0, 1), b2 + hstep, voffB);
            PG8_WAIT_V(6); PG8_BAR; PG8_MMA(1, 1, At, B1); PG8_BAR;
            PG8_LDB(B0, 1, 0); PG8_SCHED; PG8_LDA(At, 1, 0); PG8_STAGE(PG8_SA(0, 1), a2 + hstep, voffA);
            PG8_WAIT_L(8); PG8_BAR; PG8_WAIT_L(0); PG8_MMA(0, 0, At, B0); PG8_BAR; PG8_SCHED;
            PG8_LDB(B1, 1, 1); PG8_STAGE(PG8_SB(1, 0), b3, voffB);
            PG8_BAR; PG8_WAIT_L(0); PG8_MMA(0, 1, At, B1); PG8_BAR;
            PG8_LDA(At, 1, 1); PG8_STAGE(PG8_SA(1, 0), a3, voffA);
            PG8_BAR; PG8_WAIT_L(0); PG8_MMA(1, 0, At, B0); PG8_BAR; PG8_SCHED;
            PG8_STAGE(PG8_SB(1, 1), b3 + hstep, voffB);
            PG8_WAIT_V(6); PG8_BAR; PG8_MMA(1, 1, At, B1); PG8_BAR;
            }
        }
        if constexpr (ALIGN_EPI) { if (wr == 0) PG8_BAR; }
        if constexpr (!Epi::AFTER_DRAIN) { E(acc, cur, wr, wc, fr, fq); S.done(cur); }
        if (!has_next) break;
#pragma unroll
        for (int a = 0; a < 2; ++a)
#pragma unroll
            for (int b = 0; b < 2; ++b)
#pragma unroll
                for (int m = 0; m < 4; ++m)
#pragma unroll
                    for (int n = 0; n < 2; ++n) acc[a][b][m][n] = (f32x4){0.f, 0.f, 0.f, 0.f};
        cur = nxt; cA = nA; cB = nB; ++ui;
        if constexpr (ALIGN_EPI) { if (wr == 1) PG8_BAR; }
    }
    PG8_WAIT_V(0);
    if constexpr (!ALIGN_EPI) { if (wr == 0) PG8_BAR; }
    PG8_BAR;
    if constexpr (Epi::AFTER_DRAIN) { E.fused(acc, cur, wr, wc, fr, fq, lds, wid, lane); S.done(cur); }
#undef PG8_SA
#undef PG8_SB
#undef PG8_STAGE
#undef PG8_LDA
#undef PG8_LDB
#undef PG8_MMA
#undef PG8_WAIT_V
#undef PG8_WAIT_L
#undef PG8_BAR
#undef PG8_SCHED
}
}
#define LAS __attribute__((address_space(3)))
typedef unsigned short bf16_t;
typedef short bf16x8 __attribute__((ext_vector_type(8)));
typedef short s16x4 __attribute__((ext_vector_type(4)));
typedef float f32x4 __attribute__((ext_vector_type(4)));
typedef float f32x16 __attribute__((ext_vector_type(16)));
typedef unsigned u32x4 __attribute__((ext_vector_type(4)));
typedef unsigned u32x2 __attribute__((ext_vector_type(2)));
using pg8::cvt_pk_bf16;

#ifndef MK_PHM
#define MK_PHM 0xFFFF
#endif
constexpr int PHM = MK_PHM;
#ifndef MK_DUPM
#define MK_DUPM 0
#endif
constexpr int DUPM = MK_DUPM;
constexpr int NTHREADS = 512, NWAVES = 8;
constexpr int M = 16384, MCTX = 8192, DM = 1024, FF = 2816, NGU = 2 * FF, DIN = 2224, NIN = 2304, KVROWS = 16896, NLAYER = 4;
constexpr float EPS = 1e-6f, LOG2E = 1.4426950408889634f;
constexpr int LDS_BYTES = 131072 + 1024;

constexpr size_t al256(size_t x) { return (x + 255) & ~(size_t)255; }
constexpr size_t SZ_WGU1 = (size_t)NGU * DM * 2, SZ_WD1 = (size_t)DM * FF * 2, SZ_WIN1 = (size_t)NIN * DM * 2, SZ_WOUT1 = (size_t)DM * DM * 2, SZ_WUQ1 = (size_t)768 * 256 * 2, SZ_WUKV1 = (size_t)768 * 256 * 2;
constexpr size_t WS_WGU = 0;
constexpr size_t WS_WD = WS_WGU + 8 * SZ_WGU1;
constexpr size_t WS_WIN = WS_WD + 8 * SZ_WD1;
constexpr size_t WS_WOUT = WS_WIN + 4 * SZ_WIN1;
constexpr size_t WS_WUQ = WS_WOUT + 4 * SZ_WOUT1;
constexpr size_t WS_WUKV = WS_WUQ + 4 * SZ_WUQ1;
constexpr size_t WS_MODS = WS_WUKV + 4 * SZ_WUKV1;
constexpr size_t WS_ROPE64 = WS_MODS + al256((size_t)4 * 3 * 9216 * 4);
constexpr size_t WS_ROPE32 = WS_ROPE64 + (size_t)4096 * 64 * 4;
constexpr size_t WS_X = WS_ROPE32 + (size_t)4096 * 32 * 4;
constexpr size_t WS_XN = WS_X + (size_t)M * DM * 4;
constexpr size_t WS_R1 = WS_XN + (size_t)M * DM * 2;
constexpr size_t SZ_R1 = (size_t)M * FF * 2;
constexpr size_t WS_PROJ = WS_R1 + SZ_R1;
constexpr size_t WS_MLA = WS_PROJ + (size_t)M * NIN * 4;
constexpr size_t WS_MLN = WS_MLA + (size_t)2048 * 4096 * 4;
constexpr size_t WS_MLS = WS_MLN + (size_t)2048 * 64 * 4;
constexpr size_t WS_CTL = WS_MLS + (size_t)2048 * 4 * 4;
constexpr size_t CTL_BYTES = 16384;
constexpr size_t WS_END = WS_CTL + CTL_BYTES;
constexpr size_t R1_QG = 0;
constexpr size_t R1_KG = R1_QG + (size_t)M * 384 * 2;
constexpr size_t R1_VG = R1_KG + (size_t)KVROWS * 128 * 2;
constexpr size_t R1_QLATN = R1_VG + (size_t)KVROWS * 128 * 2;
constexpr size_t R1_CKV = R1_QLATN + (size_t)M * 256 * 2;
constexpr size_t R1_KROPE = R1_CKV + (size_t)KVROWS * 256 * 2;
constexpr size_t R1_QM = R1_KROPE + (size_t)KVROWS * 32 * 2;
constexpr size_t R1_KVM = R1_QM + (size_t)M * 768 * 2;
constexpr size_t R1_END = R1_KVM + (size_t)KVROWS * 768 * 2;
static_assert(R1_END <= SZ_R1, "mixer overlay fits in the ACT region");
static_assert(R1_KG % 256 == 0 && R1_VG % 256 == 0 && R1_QLATN % 256 == 0 && R1_CKV % 256 == 0 && R1_KROPE % 256 == 0 && R1_QM % 256 == 0 && R1_KVM % 256 == 0, "alignment");
static_assert(WS_MODS % 256 == 0 && WS_X % 256 == 0 && WS_R1 % 256 == 0 && WS_PROJ % 256 == 0, "alignment");

constexpr size_t O_YP = 0, O_YS = 8388608, O_GK = 16777216, O_GV = 20971520, O_CKV = 25165824, O_KR = 33554432, O_C = 34603008, O_N = 38797312, O_MM = 38862848;
constexpr int C_GQ = 0, C_GK = 384, C_GV = 512, C_MQ = 640, C_MK = 896, C_MV = 1152, C_MO = 1408, C_MG = 1664, C_QLAT = 1680, C_KVLAT = 1936, C_KROPE = 2192;

struct Args { const float* in[28]; float* out; unsigned char* ws; int ph_lo, ph_hi; };
typedef const __attribute__((address_space(4))) Args* ArgsP;

__device__ __forceinline__ float wave_sum(float v) {
#pragma unroll
    for (int o = 1; o < 64; o <<= 1) v += __shfl_xor(v, o);
    return v;
}
__device__ __forceinline__ float wave_max(float v) {
#pragma unroll
    for (int o = 1; o < 64; o <<= 1) v = fmaxf(v, __shfl_xor(v, o));
    return v;
}
__device__ __forceinline__ unsigned short bf1(float v) { return (unsigned short)(cvt_pk_bf16(v, 0.f) & 0xffffu); }
__device__ __forceinline__ int crow(int r, int hi) { return (r & 3) + 8 * (r >> 2) + 4 * hi; }
__device__ __forceinline__ float log_sigmoid(float x) { return fminf(x, 0.f) - log1pf(__expf(-fabsf(x))); }
__device__ __forceinline__ float scan_sum(float v, int lane) {
#pragma unroll
    for (int o = 1; o < 64; o <<= 1) { const float t = __shfl_up(v, o); if (lane >= o) v += t; }
    return v;
}
__device__ __forceinline__ float scan_max(float v, int lane) {
#pragma unroll
    for (int o = 1; o < 64; o <<= 1) { const float t = __shfl_up(v, o); if (lane >= o) v = fmaxf(v, t); }
    return v;
}

__device__ __forceinline__ void transpose_item(const float* W, int K, int N, bf16_t* WT, int dst_row0, int k0, int n0, LAS float* scr, int lane) {
    const int nn = n0 + (lane & 31);
#pragma unroll 8
    for (int i = 0; i < 32; ++i) { const int kk = 2 * i + (lane >> 5); scr[kk * 33 + (lane & 31)] = (nn < N) ? W[(size_t)(k0 + kk) * N + nn] : 0.f; }
    asm volatile("s_waitcnt lgkmcnt(0)" ::: "memory");
    const int c = lane & 7;
#pragma unroll
    for (int j = 0; j < 4; ++j) {
        const int n = (lane >> 3) + 8 * j; const LAS float* s = scr + (8 * c) * 33 + n;
        u32x4 o; o.x = cvt_pk_bf16(s[0 * 33], s[1 * 33]); o.y = cvt_pk_bf16(s[2 * 33], s[3 * 33]); o.z = cvt_pk_bf16(s[4 * 33], s[5 * 33]); o.w = cvt_pk_bf16(s[6 * 33], s[7 * 33]);
        *(u32x4*)(WT + (size_t)(dst_row0 + n) * K + k0 + 8 * c) = o;
    }
    asm volatile("s_waitcnt lgkmcnt(0)" ::: "memory");
}
__device__ __forceinline__ void sincos_f(float x, float& s, float& c) {
    const float k = __builtin_rintf(x * 0.63661977236758134308f);
    float r = __builtin_fmaf(-k, 1.5703125f, x); r = __builtin_fmaf(-k, 4.837512969970703125e-4f, r); r = __builtin_fmaf(-k, 7.54978995489188e-8f, r);
    const float r2 = r * r;
    float sp = 2.7557319e-6f; sp = sp * r2 - 1.9841270e-4f; sp = sp * r2 + 8.3333333e-3f; sp = sp * r2 - 1.6666667e-1f; sp = sp * r2 * r + r;
    float cp = 2.4801587e-5f; cp = cp * r2 - 1.3888889e-3f; cp = cp * r2 + 4.1666667e-2f; cp = cp * r2 - 0.5f; cp = cp * r2 + 1.0f;
    const int q = ((int)k) & 3;
    s = (q == 0) ? sp : (q == 1) ? cp : (q == 2) ? -sp : -cp;
    c = (q == 0) ? cp : (q == 1) ? -sp : (q == 2) ? -cp : sp;
}
__device__ __forceinline__ float rope_freq16(int fi) {
    const int a = fi & 3, b = fi >> 2;
    const float f = (a == 0) ? 1.0f : (a == 1) ? 0.56234132519034908f : (a == 2) ? 0.31622776601683794f : 0.17782794100389228f;
    const float g = (b == 0) ? 1.0f : (b == 1) ? 0.1f : (b == 2) ? 0.01f : 0.001f;
    return f * g;
}
struct TDesc { int in_idx, K, N, nb, mode, items; unsigned long long ws_off, dst_bytes; };
__device__ const TDesc TD[7] = {
    {14, 1024, 2816, 88, 1, 8 * 16 * 88, WS_WGU, SZ_WGU1},
    {15, 1024, 2816, 88, 2, 8 * 16 * 88, WS_WGU, SZ_WGU1},
    {16, 2816, 1024, 32, 0, 8 * 44 * 32, WS_WD, SZ_WD1},
    {17, 1024, 2224, 72, 0, 4 * 16 * 72, WS_WIN, SZ_WIN1},
    {26, 1024, 1024, 32, 0, 4 * 16 * 32, WS_WOUT, SZ_WOUT1},
    {23, 256, 576, 24, 0, 4 * 4 * 24, WS_WUQ, SZ_WUQ1},
    {25, 256, 768, 24, 0, 4 * 4 * 24, WS_WUKV, SZ_WUKV1}};
__device__ __forceinline__ void phase_prologue(ArgsP a, LAS unsigned char* lds) {
    const int tid = pg8::lt_tid(), lane = tid & 63, wave = tid >> 6;
    const int G = gridDim.x, gw = blockIdx.x * NWAVES + wave, NGW = G * NWAVES;
    unsigned char* ws = a->ws;
    {
        LAS float* scr = (LAS float*)(lds + wave * 8704);
        int total = 0;
#pragma unroll 1
        for (int d = 0; d < 7; ++d) total += TD[d].items;
#pragma unroll 1
        for (int it = gw; it < total; it += NGW) {
            int d = 0, r = it;
#pragma unroll 1
            while (r >= TD[d].items) { r -= TD[d].items; ++d; }
            const int K = TD[d].K, N = TD[d].N, nb = TD[d].nb, mode = TD[d].mode, per_mat = (K >> 6) * nb;
            const int m = r / per_mat, sub = r % per_mat, kb = sub / nb, n0 = (sub % nb) * 32;
            const float* W = a->in[TD[d].in_idx] + (size_t)m * K * N;
            bf16_t* WT = (bf16_t*)(ws + TD[d].ws_off + (size_t)m * TD[d].dst_bytes);
            const int drow = mode == 0 ? n0 : (n0 >> 7) * 256 + (mode == 2 ? 128 : 0) + (n0 & 127);
            transpose_item(W, K, N, WT, drow, kb * 64, n0, scr, lane);
        }
    }
    __syncthreads();
    {
        LAS float* sc = (LAS float*)lds;
        LAS float* red = (LAS float*)(lds + 12288);
        for (int i = tid; i < 3072; i += NTHREADS) { const int cd = i >> 10, k = i & 1023; const float v = (cd == 0) ? a->in[10][k] : a->in[2][(cd - 1) * 1024 + k]; sc[i] = v / (1.0f + __expf(-v)); }
        __syncthreads();
        float* mods = (float*)(ws + WS_MODS);
        const int kp = tid >> 6, ci = tid & 63;
        for (int it = blockIdx.x; it < NLAYER * 144; it += G) {
            const int l = it / 144, n0 = (it % 144) * 64;
            const float* W = a->in[11] + (size_t)l * DM * 9216 + n0 + ci;
            float a0 = 0.f, a1 = 0.f, a2 = 0.f;
#pragma unroll 8
            for (int k = kp * 128; k < kp * 128 + 128; ++k) { const float w = W[(size_t)k * 9216]; a0 += sc[k] * w; a1 += sc[1024 + k] * w; a2 += sc[2048 + k] * w; }
            red[(kp * 3 + 0) * 64 + ci] = a0; red[(kp * 3 + 1) * 64 + ci] = a1; red[(kp * 3 + 2) * 64 + ci] = a2;
            __syncthreads();
            if (tid < 192) { const int cd = tid >> 6; float s = a->in[12][(size_t)l * 9216 + n0 + ci];
#pragma unroll
                for (int q = 0; q < 8; ++q) s += red[(q * 3 + cd) * 64 + ci];
                mods[((size_t)l * 3 + cd) * 9216 + n0 + ci] = s; }
            __syncthreads();
        }
    }
    {
        f32x4* X = (f32x4*)(ws + WS_X);
        const f32x4* xp = (const f32x4*)a->in[0]; const f32x4* xs = (const f32x4*)a->in[1];
        const size_t half = (size_t)MCTX * DM / 4;
        for (size_t i = (size_t)blockIdx.x * NTHREADS + tid; i < half; i += (size_t)G * NTHREADS) { X[i] = xp[i]; X[half + i] = xs[i]; }
    }
    {
        float* r64 = (float*)(ws + WS_ROPE64); float* r32 = (float*)(ws + WS_ROPE32);
        for (int i = blockIdx.x * NTHREADS + tid; i < 4096 * 32 + 4096 * 16; i += G * NTHREADS) {
            if (i < 4096 * 32) { const int t = i >> 5, j = i & 31; const int pos = (j < 16) ? (t >> 6) : (t & 63); const float ang = (float)pos * rope_freq16(j & 15);
                float s, c; sincos_f(ang, s, c); r64[(size_t)t * 64 + j] = c; r64[(size_t)t * 64 + 32 + j] = s; }
            else { const int ii = i - 4096 * 32; const int t = ii >> 4, j = ii & 15; const int pos = (j < 8) ? (t >> 6) : (t & 63); const float ang = (float)pos * rope_freq16(2 * (j & 7));
                float s, c; sincos_f(ang, s, c); r32[(size_t)t * 32 + j] = c; r32[(size_t)t * 32 + 16 + j] = s; }
        }
    }
}

__device__ __forceinline__ void phase_norm(ArgsP a, int l, int which) {
    const int tid = pg8::lt_tid(), lane = tid & 63, wave = tid >> 6;
    const int gw = blockIdx.x * NWAVES + wave, NGW = gridDim.x * NWAVES;
    const float* X = (const float*)(a->ws + WS_X); bf16_t* XN = (bf16_t*)(a->ws + WS_XN);
    const float* nw = a->in[13] + (size_t)(l * 3 + which) * 1024;
    const float* mods = (const float*)(a->ws + WS_MODS) + (size_t)l * 3 * 9216;
    for (int row = gw; row < M; row += NGW) {
        const int cond = row < MCTX ? 0 : 1 + ((row - MCTX) >> 12);
        const float* sh = mods + cond * 9216 + (3 * which) * 1024; const float* sc = sh + 1024;
        const f32x4* xr = (const f32x4*)(X + (size_t)row * DM) + lane;
        f32x4 v[4]; float s = 0.f;
#pragma unroll
        for (int j = 0; j < 4; ++j) { v[j] = xr[64 * j]; s += (v[j].x * v[j].x + v[j].y * v[j].y) + (v[j].z * v[j].z + v[j].w * v[j].w); }
        const float rstd = 1.0f / sqrtf(wave_sum(s) * (1.0f / DM) + EPS);
        u32x2* o = (u32x2*)(XN + (size_t)row * DM) + lane;
#pragma unroll
        for (int j = 0; j < 4; ++j) {
            const int col = 4 * lane + 256 * j;
            const f32x4 w = *(const f32x4*)(nw + col), cs = *(const f32x4*)(sc + col), hs = *(const f32x4*)(sh + col);
            const f32x4 h = v[j] * rstd * w * (cs + 1.0f) + hs;
            u32x2 p; p.x = cvt_pk_bf16(h.x, h.y); p.y = cvt_pk_bf16(h.z, h.w); o[64 * j] = p;
        }
    }
}
__device__ __forceinline__ void phase_final_norm(ArgsP a) {
    const int tid = pg8::lt_tid(), lane = tid & 63, wave = tid >> 6;
    const int gw = blockIdx.x * NWAVES + wave, NGW = gridDim.x * NWAVES;
    const float* X = (const float*)(a->ws + WS_X); const float* nw = a->in[27];
    for (int row = gw; row < M; row += NGW) {
        const f32x4* xr = (const f32x4*)(X + (size_t)row * DM) + lane;
        f32x4 v[4]; float s = 0.f;
#pragma unroll
        for (int j = 0; j < 4; ++j) { v[j] = xr[64 * j]; s += (v[j].x * v[j].x + v[j].y * v[j].y) + (v[j].z * v[j].z + v[j].w * v[j].w); }
        const float rstd = 1.0f / sqrtf(wave_sum(s) * (1.0f / DM) + EPS);
        f32x4* o = (f32x4*)(a->out + (size_t)row * DM) + lane;
#pragma unroll
        for (int j = 0; j < 4; ++j) o[64 * j] = v[j] * rstd * *(const f32x4*)(nw + 4 * lane + 256 * j);
    }
}

__device__ __forceinline__ void phase_prep(ArgsP a, int l) {
    const int tid = pg8::lt_tid(), lane = tid & 63, wave = tid >> 6;
    const int gw = blockIdx.x * NWAVES + wave, NGW = gridDim.x * NWAVES;
    unsigned char* r1 = a->ws + WS_R1;
    bf16_t* QG = (bf16_t*)(r1 + R1_QG); bf16_t* KG = (bf16_t*)(r1 + R1_KG); bf16_t* VG = (bf16_t*)(r1 + R1_VG);
    bf16_t* QLATN = (bf16_t*)(r1 + R1_QLATN); bf16_t* CKV = (bf16_t*)(r1 + R1_CKV); bf16_t* KROPE = (bf16_t*)(r1 + R1_KROPE);
    const float* PROJ = (const float*)(a->ws + WS_PROJ);
    const float* R64 = (const float*)(a->ws + WS_ROPE64); const float* R32 = (const float*)(a->ws + WS_ROPE32);
    const float* qn = a->in[18] + l * 64; const float* kn = a->in[19] + l * 64;
    const float* mqn = a->in[22] + l * 256; const float* mkvn = a->in[24] + l * 256;
    const float qscale = 0.125f * LOG2E;
    for (int it = gw; it < M + 512; it += NGW) {
        if (it < M) {
            const int row = it; const bool lat = row >= MCTX;
            const int b = lat ? (row - MCTX) >> 12 : row >> 8, t = lat ? (row - MCTX) & 4095 : row & 255;
            const int kvrow = lat ? MCTX + b * 4352 + 256 + t : row;
            const float* pr = PROJ + (size_t)row * NIN;
            const size_t octx = ((size_t)(b * 4 + l) * 256 + t);
            float c64 = 0.f, s64 = 0.f;
            if (lat) { c64 = R64[(size_t)t * 64 + (lane & 31)]; s64 = R64[(size_t)t * 64 + 32 + (lane & 31)]; }
            const float qnw = qn[lane], knw = kn[lane];
#pragma unroll
            for (int h = 0; h < 6; ++h) {
                const float v = pr[C_GQ + 64 * h + lane];
                float y = v * (1.0f / sqrtf(wave_sum(v * v) * (1.0f / 64.0f) + EPS)) * qnw;
                if (lat) { const float p = __shfl_xor(y, 32); y = (lane < 32) ? (y * c64 - p * s64) : (p * s64 + y * c64); }
                QG[(size_t)row * 384 + 64 * h + lane] = bf1(y * qscale);
            }
#pragma unroll
            for (int kvh = 0; kvh < 2; ++kvh) {
                const float v = pr[C_GK + 64 * kvh + lane];
                float y = v * (1.0f / sqrtf(wave_sum(v * v) * (1.0f / 64.0f) + EPS)) * knw;
                if (!lat) a->out[O_GK + octx * 128 + 64 * kvh + lane] = y;
                else { const float p = __shfl_xor(y, 32); y = (lane < 32) ? (y * c64 - p * s64) : (p * s64 + y * c64); }
                KG[(size_t)kvrow * 128 + 64 * kvh + lane] = bf1(y);
                const float vv = pr[C_GV + 64 * kvh + lane];
                if (!lat) a->out[O_GV + octx * 128 + 64 * kvh + lane] = vv;
                VG[(size_t)kvrow * 128 + 64 * kvh + lane] = bf1(vv);
            }
            {
                const f32x4 v = *(const f32x4*)(pr + C_QLAT + 4 * lane);
                const float rstd = 1.0f / sqrtf(wave_sum((v.x * v.x + v.y * v.y) + (v.z * v.z + v.w * v.w)) * (1.0f / 256.0f) + EPS);
                const f32x4 y = v * rstd * *(const f32x4*)(mqn + 4 * lane);
                u32x2 p; p.x = cvt_pk_bf16(y.x, y.y); p.y = cvt_pk_bf16(y.z, y.w); *(u32x2*)(QLATN + (size_t)row * 256 + 4 * lane) = p;
            }
            {
                const f32x4 v = *(const f32x4*)(pr + C_KVLAT + 4 * lane);
                const float rstd = 1.0f / sqrtf(wave_sum((v.x * v.x + v.y * v.y) + (v.z * v.z + v.w * v.w)) * (1.0f / 256.0f) + EPS);
                const f32x4 y = v * rstd * *(const f32x4*)(mkvn + 4 * lane);
                if (!lat) *(f32x4*)(a->out + O_CKV + octx * 256 + 4 * lane) = y;
                u32x2 p; p.x = cvt_pk_bf16(y.x, y.y); p.y = cvt_pk_bf16(y.z, y.w); *(u32x2*)(CKV + (size_t)kvrow * 256 + 4 * lane) = p;
            }
            {
                float v = pr[C_KROPE + (lane & 31)];
                if (!lat) { if (lane < 32) a->out[O_KR + octx * 32 + lane] = v; }
                else { const float c = R32[(size_t)t * 32 + (lane & 15)], s = R32[(size_t)t * 32 + 16 + (lane & 15)]; const float p = __shfl_xor(v, 16); v = (lane & 16) ? (p * s + v * c) : (v * c - p * s); }
                if (lane < 32) KROPE[(size_t)kvrow * 32 + lane] = bf1(v);
            }
        } else {
            const int idx = it - M, b = idx >> 8, s = idx & 255; const int kvrow = MCTX + b * 4352 + s;
            const size_t crow_ = (size_t)(b * 4 + l) * 256 + s;
            const float* ck = a->in[3] + crow_ * 128; const float* cv = a->in[4] + crow_ * 128;
#pragma unroll
            for (int kvh = 0; kvh < 2; ++kvh) {
                KG[(size_t)kvrow * 128 + 64 * kvh + lane] = bf1(ck[64 * kvh + lane]);
                VG[(size_t)kvrow * 128 + 64 * kvh + lane] = bf1(cv[64 * kvh + lane]);
            }
            const f32x4 y = *(const f32x4*)(a->in[5] + crow_ * 256 + 4 * lane);
            u32x2 p; p.x = cvt_pk_bf16(y.x, y.y); p.y = cvt_pk_bf16(y.z, y.w); *(u32x2*)(CKV + (size_t)kvrow * 256 + 4 * lane) = p;
            if (lane < 32) KROPE[(size_t)kvrow * 32 + lane] = bf1(a->in[6][crow_ * 32 + lane]);
        }
    }
    {
        float* LA = (float*)(a->ws + WS_MLA); float* LN = (float*)(a->ws + WS_MLN); float* LS = (float*)(a->ws + WS_MLS);
        const float* gb = a->in[20] + l * 16;
        const int hi = lane >> 5, l31 = lane & 31;
        for (int u = gw; u < 2048; u += NGW) {
            int h, d, c, rowbase;
            if (u < 1024) { const int bb = u >> 5; h = (u >> 3) & 3; d = (u >> 2) & 1; c = u & 3; rowbase = bb * 256; }
            else { const int v = u - 1024; const int b = v >> 9; h = (v >> 7) & 3; d = (v >> 6) & 1; c = v & 63; rowbase = MCTX + b * 4096; }
            const int r0 = rowbase + 64 * c;
            const float* pr = PROJ + (size_t)(r0 + lane) * NIN + C_MG;
            const float li = pr[(2 * d) * 4 + h] + gb[(2 * d) * 4 + h];
            const float lf = log_sigmoid(pr[(2 * d + 1) * 4 + h] + gb[(2 * d + 1) * 4 + h]);
            float bcum;
            if (d == 0) bcum = scan_sum(lf, lane); else { const float rv = __shfl(lf, 63 - lane); bcum = __shfl(scan_sum(rv, lane), 63 - lane); }
            const float bL = __shfl(bcum, d == 0 ? 63 : 0);
            const float decay = bL - bcum + li;
            const float mloc = wave_max(decay);
            const float w = __expf(decay - mloc);
            f32x16 acc[2][2];
#pragma unroll
            for (int i = 0; i < 2; ++i)
#pragma unroll
                for (int j = 0; j < 2; ++j) acc[i][j] = f32x16{};
            float nacc0 = 0.f, nacc1 = 0.f;
            const float* kbase = PROJ + (size_t)r0 * NIN + C_MK + 64 * h + l31;
            const float* vbase = PROJ + (size_t)r0 * NIN + C_MV + 64 * h + l31;
#pragma unroll 4
            for (int j = 0; j < 32; ++j) {
                const int s = 2 * j + hi;
                const float wsv = __shfl(w, s);
                const float k0 = kbase[(size_t)s * NIN] * wsv, k1 = kbase[(size_t)s * NIN + 32] * wsv;
                const float v0 = vbase[(size_t)s * NIN], v1 = vbase[(size_t)s * NIN + 32];
                acc[0][0] = __builtin_amdgcn_mfma_f32_32x32x2f32(k0, v0, acc[0][0], 0, 0, 0);
                acc[0][1] = __builtin_amdgcn_mfma_f32_32x32x2f32(k0, v1, acc[0][1], 0, 0, 0);
                acc[1][0] = __builtin_amdgcn_mfma_f32_32x32x2f32(k1, v0, acc[1][0], 0, 0, 0);
                acc[1][1] = __builtin_amdgcn_mfma_f32_32x32x2f32(k1, v1, acc[1][1], 0, 0, 0);
                nacc0 += k0; nacc1 += k1;
            }
            nacc0 += __shfl_xor(nacc0, 32); nacc1 += __shfl_xor(nacc1, 32);
            float* Au = LA + (size_t)u * 4096;
#pragma unroll
            for (int dkb = 0; dkb < 2; ++dkb)
#pragma unroll
                for (int dvb = 0; dvb < 2; ++dvb)
#pragma unroll
                    for (int r = 0; r < 16; ++r) Au[(32 * dkb + crow(r, hi)) * 64 + 32 * dvb + l31] = acc[dkb][dvb][r];
            if (hi == 0) { LN[(size_t)u * 64 + l31] = nacc0; LN[(size_t)u * 64 + 32 + l31] = nacc1; }
            if (lane == 0) { LS[(size_t)u * 4 + 0] = bL; LS[(size_t)u * 4 + 1] = mloc; }
        }
    }
}

__device__ __forceinline__ void mlstm_scan_chain(ArgsP a, int l, int chain_is_lat, int chain, int e) {
    float* LA = (float*)(a->ws + WS_MLA); float* LN = (float*)(a->ws + WS_MLN); float* LS = (float*)(a->ws + WS_MLS);
    float C, n = 0.f, m; int nc, ubase; const int d = chain & 1, h = (chain >> 1) & 3, bb = chain >> 3;
    if (chain_is_lat) {
        const size_t sidx = ((size_t)(bb * 4 + l) * 2 + d) * 4 + h;
        C = a->in[7][sidx * 4096 + e]; if (e < 64) n = a->in[8][sidx * 64 + e]; m = a->in[9][sidx];
        nc = 64; ubase = 1024 + chain * 64;
    } else { C = 0.f; m = 0.f; nc = 4; ubase = chain * 4; }
#pragma unroll 1
    for (int s0 = 0; s0 < nc; s0 += 4) {
        float bLv[4], mlv[4], av[4], anv[4];
#pragma unroll
        for (int i = 0; i < 4; ++i) {
            const int c = d == 0 ? s0 + i : nc - 1 - (s0 + i); const size_t u = (size_t)(ubase + c);
            bLv[i] = LS[u * 4 + 0]; mlv[i] = LS[u * 4 + 1]; av[i] = LA[u * 4096 + e]; anv[i] = (e < 64) ? LN[u * 64 + e] : 0.f;
        }
#pragma unroll
        for (int i = 0; i < 4; ++i) {
            const int c = d == 0 ? s0 + i : nc - 1 - (s0 + i); const size_t u = (size_t)(ubase + c);
            LA[u * 4096 + e] = C; if (e < 64) LN[u * 64 + e] = n; if (e == 0) LS[u * 4 + 2] = m;
            const float mnew = fmaxf(bLv[i] + m, mlv[i]);
            const float wold = __expf(bLv[i] + m - mnew), wloc = __expf(mlv[i] - mnew);
            C = wold * C + wloc * av[i]; n = wold * n + wloc * anv[i]; m = mnew;
        }
    }
    if (!chain_is_lat) {
        const size_t sidx = ((size_t)(bb * 4 + l) * 2 + d) * 4 + h;
        a->out[O_C + sidx * 4096 + e] = C; if (e < 64) a->out[O_N + sidx * 64 + e] = n; if (e == 0) a->out[O_MM + sidx] = m;
    }
}
__device__ __forceinline__ void phase_mlstm_scan(ArgsP a, int l) {
    int bxl = blockIdx.x; asm volatile("" : "+s"(bxl));
    const int NT = gridDim.x * NTHREADS, gt = bxl * NTHREADS + pg8::lt_tid();
    constexpr int NLAT = 16 * 4096, NCTX = 256 * 4096;
    for (int task = gt; task < NLAT; task += NT) mlstm_scan_chain(a, l, 1, task >> 12, task & 4095);
    if (NT > NLAT) { if (gt >= NLAT) for (int k = gt - NLAT; k < NCTX; k += NT - NLAT) mlstm_scan_chain(a, l, 0, k >> 12, k & 4095); }
    else for (int k = gt; k < NCTX; k += NT) mlstm_scan_chain(a, l, 0, k >> 12, k & 4095);
}

__device__ __forceinline__ void phase_mlstm_out(ArgsP a, int l) {
    const int tid = pg8::lt_tid(), lane = tid & 63, wave = tid >> 6, hi = lane >> 5, l31 = lane & 31;
    const int G = gridDim.x;
    const float* PROJ = (const float*)(a->ws + WS_PROJ);
    const float* LA = (const float*)(a->ws + WS_MLA); const float* LN = (const float*)(a->ws + WS_MLN); const float* LS = (const float*)(a->ws + WS_MLS);
    bf16_t* CAT = (bf16_t*)(a->ws + WS_XN);
    const float* gb = a->in[20] + l * 16; const float* onw = a->in[21] + l * 256;
    for (int item = wave * G + blockIdx.x; item < 2048; item += NWAVES * G) {
        const int u2 = item >> 1, tb = item & 1;
        int h, c, rowbase, ul0, ulstride;
        if (u2 < 512) { const int bb = u2 >> 4; h = (u2 >> 2) & 3; c = u2 & 3; rowbase = bb * 256; ul0 = ((bb * 4 + h) * 2) * 4 + c; ulstride = 4; }
        else { const int v = u2 - 512; const int b = v >> 8; h = (v >> 6) & 3; c = v & 63; rowbase = MCTX + b * 4096; ul0 = 1024 + ((b * 4 + h) * 2) * 64 + c; ulstride = 64; }
        const int r0 = rowbase + 64 * c;
        const float* prg = PROJ + (size_t)(r0 + lane) * NIN + C_MG;
        {
            const int tau = 32 * tb + l31;
            f32x16 hsum[2]; hsum[0] = f32x16{}; hsum[1] = f32x16{};
#pragma unroll 1
            for (int d = 0; d < 2; ++d) {
                const size_t ul = (size_t)(ul0 + d * ulstride);
                const float m_in = LS[ul * 4 + 2];
                const float* Cin = LA + ul * 4096; const float* nin = LN + ul * 64;
                const float li = prg[(2 * d) * 4 + h] + gb[(2 * d) * 4 + h];
                const float lf = log_sigmoid(prg[(2 * d + 1) * 4 + h] + gb[(2 * d + 1) * 4 + h]);
                float bcum, pm;
                if (d == 0) { bcum = scan_sum(lf, lane); pm = scan_max(li - bcum, lane); }
                else { const float rv = __shfl(lf, 63 - lane); bcum = __shfl(scan_sum(rv, lane), 63 - lane); const float ru = __shfl(li - bcum, 63 - lane); pm = __shfl(scan_max(ru, lane), 63 - lane); }
                const float uu = li - bcum;
                const float Mx = fmaxf(m_in, pm);
                const float M_t = __shfl(Mx, tau), b_t = __shfl(bcum, tau);
                const float winter = __expf(m_in - M_t);
                const float* qrow = PROJ + (size_t)(r0 + tau) * NIN + C_MQ + 64 * h + 32 * hi;
                float qn = 0.f;
#pragma unroll 1
                for (int j = 0; j < 8; ++j) { const f32x4 q4 = *(const f32x4*)(qrow + 4 * j), n4 = *(const f32x4*)(nin + 32 * hi + 4 * j); qn += (q4.x * n4.x + q4.y * n4.y) + (q4.z * n4.z + q4.w * n4.w); }
                qn = (qn + __shfl_xor(qn, 32)) * 0.125f;
                f32x16 o[2]; o[0] = f32x16{}; o[1] = f32x16{};
                float densum = 0.f;
                const float qsc = 0.125f * winter;
                {
                    const float* cbase = Cin + (size_t)(32 * hi) * 64 + l31;
#pragma unroll 1
                    for (int j = 0; j < 8; ++j) {
                        const f32x4 q4 = *(const f32x4*)(qrow + 4 * j) * qsc;
                        const float* cp = cbase + (size_t)(4 * j) * 64;
#pragma unroll
                        for (int i = 0; i < 4; ++i) {
                            o[0] = __builtin_amdgcn_mfma_f32_32x32x2f32(cp[i * 64], q4[i], o[0], 0, 0, 0);
                            o[1] = __builtin_amdgcn_mfma_f32_32x32x2f32(cp[i * 64 + 32], q4[i], o[1], 0, 0, 0);
                        }
                    }
                }
#pragma unroll 1
                for (int sb = 0; sb < 2; ++sb) {
                    const bool act = (d == 0) ? (sb <= tb) : (sb >= tb);
                    if (act) {
                        f32x16 p = f32x16{};
                        const float* krow = PROJ + (size_t)(r0 + 32 * sb + l31) * NIN + C_MK + 64 * h + 32 * hi;
#pragma unroll 1
                        for (int j = 0; j < 8; ++j) {
                            const f32x4 k4 = *(const f32x4*)(krow + 4 * j), q4 = *(const f32x4*)(qrow + 4 * j) * 0.125f;
#pragma unroll
                            for (int i = 0; i < 4; ++i) p = __builtin_amdgcn_mfma_f32_32x32x2f32(k4[i], q4[i], p, 0, 0, 0);
                        }
                        const float* vb0 = PROJ + (size_t)(r0 + 32 * sb + 4 * hi) * NIN + C_MV + 64 * h + l31;
#pragma unroll
                        for (int r = 0; r < 16; ++r) {
                            const int s = 32 * sb + crow(r, hi);
                            const float us = __shfl(uu, s);
                            const bool ok = (d == 0) ? (s <= tau) : (s >= tau);
                            const float pv = ok ? p[r] * __expf(us - M_t) : 0.f;
                            densum += pv;
                            const float* vp = vb0 + (size_t)((r & 3) + 8 * (r >> 2)) * NIN;
                            o[0] = __builtin_amdgcn_mfma_f32_32x32x2f32(vp[0], pv, o[0], 0, 0, 0);
                            o[1] = __builtin_amdgcn_mfma_f32_32x32x2f32(vp[32], pv, o[1], 0, 0, 0);
                            if ((r & 3) == 3) __builtin_amdgcn_sched_barrier(0);
                        }
                    }
                }
                densum += __shfl_xor(densum, 32);
                const float den = winter * qn + densum;
                const float dnm = fmaxf(fabsf(den), __expf(-(b_t + M_t)));
                const float inv = 1.0f / dnm;
#pragma unroll
                for (int r = 0; r < 16; ++r) { hsum[0][r] += o[0][r] * inv; hsum[1][r] += o[1][r] * inv; }
            }
            float ss = 0.f;
#pragma unroll
            for (int r = 0; r < 16; ++r) ss += hsum[0][r] * hsum[0][r] + hsum[1][r] * hsum[1][r];
            ss += __shfl_xor(ss, 32);
            const float rstd = 1.0f / sqrtf(ss * (1.0f / 64.0f) + EPS);
            const size_t row = (size_t)(r0 + tau);
            const float* mo = PROJ + row * NIN + C_MO + 64 * h;
#pragma unroll
            for (int dvb = 0; dvb < 2; ++dvb)
#pragma unroll
                for (int g = 0; g < 4; ++g) {
                    const int dv = 32 * dvb + 8 * g + 4 * hi;
                    const f32x4 og = *(const f32x4*)(mo + dv), nw4 = *(const f32x4*)(onw + 64 * h + dv);
                    float y[4];
#pragma unroll
                    for (int i = 0; i < 4; ++i) y[i] = hsum[dvb][4 * g + i] * rstd * nw4[i] * (1.0f / (1.0f + __expf(-og[i])));
                    u32x2 pk; pk.x = cvt_pk_bf16(y[0], y[1]); pk.y = cvt_pk_bf16(y[2], y[3]);
                    *(u32x2*)(CAT + row * 1024 + 384 + 64 * h + dv) = pk;
                }
        }
    }
}

template <int DQK>
__device__ __forceinline__ void attn_unit(const bf16_t* Qb, int qstride, const bf16_t* Kb, int kstride, const bf16_t* Krope, const bf16_t* Vb, int vstride, int S, bf16_t* Ob, LAS unsigned char* lds, const float* rope32, int t0) {
    constexpr int KST = DQK * 2 + 16, VST = 144, KBUF = 64 * KST, VBUF = 64 * VST, NQ = DQK / 16;
    const int tid = pg8::lt_tid(), lane = tid & 63, wave = tid >> 6, hi = lane >> 5, l31 = lane & 31;
    LAS unsigned char* Kl = lds; LAS unsigned char* Vl = lds + 2 * KBUF;
    bf16x8 q[NQ];
    { const bf16_t* qp = Qb + (size_t)(wave * 32 + l31) * qstride + 8 * hi;
#pragma unroll
      for (int i = 0; i < NQ; ++i) q[i] = *(const bf16x8*)(qp + 16 * i); }
    if constexpr (DQK == 96) {
        if (rope32) {
            const float* rp = rope32 + (size_t)(t0 + wave * 32 + l31) * 32 + 8 * hi;
            const f32x4 c0 = *(const f32x4*)(rp), c1 = *(const f32x4*)(rp + 4), s0 = *(const f32x4*)(rp + 16), s1 = *(const f32x4*)(rp + 20);
            float y1[8], y2[8];
#pragma unroll
            for (int e = 0; e < 8; ++e) {
                const float x1 = __uint_as_float(((unsigned)(unsigned short)q[4][e]) << 16), x2 = __uint_as_float(((unsigned)(unsigned short)q[5][e]) << 16);
                const float c = e < 4 ? c0[e & 3] : c1[e & 3], sn = e < 4 ? s0[e & 3] : s1[e & 3];
                y1[e] = x1 * c - x2 * sn; y2[e] = x1 * sn + x2 * c;
            }
            u32x4 w1 = u32x4{cvt_pk_bf16(y1[0], y1[1]), cvt_pk_bf16(y1[2], y1[3]), cvt_pk_bf16(y1[4], y1[5]), cvt_pk_bf16(y1[6], y1[7])};
            u32x4 w2 = u32x4{cvt_pk_bf16(y2[0], y2[1]), cvt_pk_bf16(y2[2], y2[3]), cvt_pk_bf16(y2[4], y2[5]), cvt_pk_bf16(y2[6], y2[7])};
            q[4] = __builtin_bit_cast(bf16x8, w1); q[5] = __builtin_bit_cast(bf16x8, w2);
        }
    }
    const int kkey = tid >> 3, kch = tid & 7, rkey = (tid >> 2) & 63, rch = tid & 3;
    const bf16_t* ksrc = Kb + (size_t)kkey * kstride + kch * 8;
    const bf16_t* rsrc = (DQK == 96) ? Krope + (size_t)rkey * 32 + rch * 8 : nullptr;
    const int vkey = tid & 63, vch = tid >> 6;
    const bf16_t* vsrc = Vb + (size_t)vkey * vstride + vch * 8;
    const int kdst = kkey * KST + kch * 16, rdst = rkey * KST + 128 + rch * 16, vdst = (vch * 8) * VST + vkey * 2;
    u32x4 kreg, rreg = u32x4{}, vreg;
    const int nt = S / 64;
    kreg = *(const u32x4*)ksrc; vreg = *(const u32x4*)vsrc; if (DQK == 96 && tid < 256) rreg = *(const u32x4*)rsrc;
    __syncthreads();
    *(LAS u32x4*)(Kl + kdst) = kreg; if (DQK == 96 && tid < 256) *(LAS u32x4*)(Kl + rdst) = rreg;
#define VT_STORE(buf) do { LAS unsigned short* vp_ = (LAS unsigned short*)(Vl + (buf) * VBUF + vdst); \
        vp_[0] = (unsigned short)(vreg.x & 0xffffu); vp_[VST / 2] = (unsigned short)(vreg.x >> 16); vp_[2 * (VST / 2)] = (unsigned short)(vreg.y & 0xffffu); vp_[3 * (VST / 2)] = (unsigned short)(vreg.y >> 16); \
        vp_[4 * (VST / 2)] = (unsigned short)(vreg.z & 0xffffu); vp_[5 * (VST / 2)] = (unsigned short)(vreg.z >> 16); vp_[6 * (VST / 2)] = (unsigned short)(vreg.w & 0xffffu); vp_[7 * (VST / 2)] = (unsigned short)(vreg.w >> 16); } while (0)
    VT_STORE(0);
    __syncthreads();
    float mrun = -INFINITY, lsum = 0.f;
    f32x16 o[2]; o[0] = f32x16{}; o[1] = f32x16{};
    for (int t = 0; t < nt; ++t) {
        const int cur = t & 1;
        if (t + 1 < nt) {
            kreg = *(const u32x4*)(ksrc + (size_t)(t + 1) * 64 * kstride); vreg = *(const u32x4*)(vsrc + (size_t)(t + 1) * 64 * vstride);
            if (DQK == 96 && tid < 256) rreg = *(const u32x4*)(rsrc + (size_t)(t + 1) * 64 * 32);
        }
        __builtin_amdgcn_sched_barrier(0);
        const LAS unsigned char* kb = Kl + cur * KBUF + l31 * KST + hi * 16;
        f32x16 p0 = f32x16{}, p1 = f32x16{};
#pragma unroll
        for (int i = 0; i < NQ; ++i) {
            const bf16x8 k0 = *(const LAS bf16x8*)(kb + i * 32), k1 = *(const LAS bf16x8*)(kb + 32 * KST + i * 32);
            p0 = __builtin_amdgcn_mfma_f32_32x32x16_bf16(k0, q[i], p0, 0, 0, 0);
            p1 = __builtin_amdgcn_mfma_f32_32x32x16_bf16(k1, q[i], p1, 0, 0, 0);
            if (i == 2) __builtin_amdgcn_sched_barrier(0);
        }
        __builtin_amdgcn_sched_barrier(0);
        float mx = fmaxf(p0[0], p1[0]);
#pragma unroll
        for (int r = 1; r < 16; ++r) mx = fmaxf(mx, fmaxf(p0[r], p1[r]));
        mx = fmaxf(mx, __shfl_xor(mx, 32));
        const float mnew = fmaxf(mrun, mx);
        const float alpha = __builtin_amdgcn_exp2f(mrun - mnew);
        mrun = mnew;
        float ps = 0.f;
#pragma unroll
        for (int r = 0; r < 16; ++r) { p0[r] = __builtin_amdgcn_exp2f(p0[r] - mnew); p1[r] = __builtin_amdgcn_exp2f(p1[r] - mnew); ps += p0[r] + p1[r]; }
        lsum = lsum * alpha + ps;
#pragma unroll
        for (int r = 0; r < 16; ++r) { o[0][r] *= alpha; o[1][r] *= alpha; }
        u32x4 pw[4];
        pw[0] = u32x4{cvt_pk_bf16(p0[0], p0[1]), cvt_pk_bf16(p0[2], p0[3]), cvt_pk_bf16(p0[4], p0[5]), cvt_pk_bf16(p0[6], p0[7])};
        pw[1] = u32x4{cvt_pk_bf16(p0[8], p0[9]), cvt_pk_bf16(p0[10], p0[11]), cvt_pk_bf16(p0[12], p0[13]), cvt_pk_bf16(p0[14], p0[15])};
        pw[2] = u32x4{cvt_pk_bf16(p1[0], p1[1]), cvt_pk_bf16(p1[2], p1[3]), cvt_pk_bf16(p1[4], p1[5]), cvt_pk_bf16(p1[6], p1[7])};
        pw[3] = u32x4{cvt_pk_bf16(p1[8], p1[9]), cvt_pk_bf16(p1[10], p1[11]), cvt_pk_bf16(p1[12], p1[13]), cvt_pk_bf16(p1[14], p1[15])};
        __builtin_amdgcn_sched_barrier(0);
        const LAS unsigned char* vb = Vl + cur * VBUF + l31 * VST + hi * 8;
#pragma unroll
        for (int db = 0; db < 2; ++db)
#pragma unroll
            for (int ks = 0; ks < 4; ++ks) {
                const s16x4 lo = *(const LAS s16x4*)(vb + db * 32 * VST + ks * 32), hi4 = *(const LAS s16x4*)(vb + db * 32 * VST + ks * 32 + 16);
                const bf16x8 vf = (bf16x8){lo[0], lo[1], lo[2], lo[3], hi4[0], hi4[1], hi4[2], hi4[3]};
                o[db] = __builtin_amdgcn_mfma_f32_32x32x16_bf16(vf, __builtin_bit_cast(bf16x8, pw[ks]), o[db], 0, 0, 0);
                if (ks == 3) __builtin_amdgcn_sched_barrier(0);
            }
        __builtin_amdgcn_sched_barrier(0);
        if (t + 1 < nt) {
            const int nx = cur ^ 1;
            *(LAS u32x4*)(Kl + nx * KBUF + kdst) = kreg; VT_STORE(nx); if (DQK == 96 && tid < 256) *(LAS u32x4*)(Kl + nx * KBUF + rdst) = rreg;
        }
        __syncthreads();
    }
    lsum += __shfl_xor(lsum, 32);
    const float inv = 1.0f / lsum;
    bf16_t* op = Ob + (size_t)(wave * 32 + l31) * 1024;
#pragma unroll
    for (int db = 0; db < 2; ++db)
#pragma unroll
        for (int g = 0; g < 4; ++g) {
            u32x2 pk; pk.x = cvt_pk_bf16(o[db][4 * g] * inv, o[db][4 * g + 1] * inv); pk.y = cvt_pk_bf16(o[db][4 * g + 2] * inv, o[db][4 * g + 3] * inv);
            *(u32x2*)(op + 32 * db + 8 * g + 4 * hi) = pk;
        }
#undef VT_STORE
}
__device__ __forceinline__ void phase_attention(ArgsP a, LAS unsigned char* lds) {
    unsigned char* r1 = a->ws + WS_R1;
    const bf16_t* QG = (const bf16_t*)(r1 + R1_QG); const bf16_t* KG = (const bf16_t*)(r1 + R1_KG); const bf16_t* VG = (const bf16_t*)(r1 + R1_VG);
    const bf16_t* KROPE = (const bf16_t*)(r1 + R1_KROPE); const bf16_t* QM = (const bf16_t*)(r1 + R1_QM); const bf16_t* KVM = (const bf16_t*)(r1 + R1_KVM);
    bf16_t* CAT = (bf16_t*)(a->ws + WS_XN);
    for (int ui = blockIdx.x; ui < 768; ui += gridDim.x) {
        const int kind = ui / 192, v = ui % 192;
        if (kind == 0) {
            const int b = v / 96, h = (v / 16) % 6, qb = v & 15; const size_t row0 = MCTX + (size_t)b * 4096 + qb * 256, kv0 = MCTX + (size_t)b * 4352;
            attn_unit<96>(QM + row0 * 768 + h * 96, 768, KVM + kv0 * 768 + h * 128, 768, KROPE + kv0 * 32, KVM + kv0 * 768 + h * 128 + 64, 768, 4352, CAT + row0 * 1024 + 640 + h * 64, lds, (const float*)(a->ws + WS_ROPE32), qb * 256);
        } else if (kind == 1) {
            const int b = v / 96, kvh = (v / 48) & 1, g = (v / 16) % 3, qb = v & 15, hq = kvh * 3 + g; const size_t row0 = MCTX + (size_t)b * 4096 + qb * 256, kv0 = MCTX + (size_t)b * 4352;
            attn_unit<64>(QG + row0 * 384 + hq * 64, 384, KG + kv0 * 128 + kvh * 64, 128, nullptr, VG + kv0 * 128 + kvh * 64, 128, 4352, CAT + row0 * 1024 + hq * 64, lds, nullptr, 0);
        } else if (kind == 2) {
            const int b = v / 6, h = v % 6; const size_t row0 = (size_t)b * 256;
            attn_unit<96>(QM + row0 * 768 + h * 96, 768, KVM + row0 * 768 + h * 128, 768, KROPE + row0 * 32, KVM + row0 * 768 + h * 128 + 64, 768, 256, CAT + row0 * 1024 + 640 + h * 64, lds, nullptr, 0);
        } else {
            const int b = v / 6, hq = v % 6, kvh = hq / 3; const size_t row0 = (size_t)b * 256;
            attn_unit<64>(QG + row0 * 384 + hq * 64, 384, KG + row0 * 128 + kvh * 64, 128, nullptr, VG + row0 * 128 + kvh * 64, 128, 256, CAT + row0 * 1024 + hq * 64, lds, nullptr, 0);
        }
    }
}

#define XB_TMO      128
#define XB_XCNT(j)  (256  + 64 * (j))
#define XB_XSUB(j)  (1280 + 64 * (j))
#define XB_XGEN(j)  (2304 + 64 * (j))
#define XB_TOP      3328
#define XB_TOPGEN   3392
#define XCD_BAR_WORDS 3456
#define XB_SPIN_CAP (1u << 18)

__device__ __forceinline__ unsigned xb_ld(unsigned* p)              { return __hip_atomic_load(p, __ATOMIC_RELAXED, __HIP_MEMORY_SCOPE_AGENT); }
__device__ __forceinline__ unsigned xb_add(unsigned* p, unsigned v) { return __hip_atomic_fetch_add(p, v, __ATOMIC_RELAXED, __HIP_MEMORY_SCOPE_AGENT); }
__device__ __forceinline__ unsigned xb_xcc_id() { return (unsigned)__builtin_amdgcn_s_getreg((3 << 11) | 20) & 0xFu; }
#define XB_SPIN(cond, bar) do { unsigned _sp = 0; while (cond) { __builtin_amdgcn_s_sleep(1); \
    if ((++_sp & 255u) == 0u) { if (xb_ld(&(bar)[XB_TMO])) break; if (_sp > XB_SPIN_CAP) { atomicAdd(&(bar)[XB_TMO], 1u); break; } } } } while (0)

struct XcdBarrier {
    unsigned* bar; unsigned x;
    volatile LAS unsigned* st;
};

__device__ __forceinline__ XcdBarrier xcd_barrier_post(unsigned* bar, volatile LAS unsigned* st) {
    XcdBarrier b; b.bar = bar; b.x = xb_xcc_id(); b.st = st;
    if (threadIdx.x == 0) (void)xb_add(&bar[XB_XCNT(b.x)], 1u);
    return b;
}
__device__ __forceinline__ void xcd_barrier_complete(unsigned* bar, unsigned x, unsigned& nloc, unsigned& nx) {
    const unsigned G = gridDim.x * gridDim.y * gridDim.z;
    unsigned sum, cnt, mine, sp = 0u;
    for (;;) {
        sum = 0u; cnt = 0u; mine = 0u;
#pragma unroll
        for (unsigned j = 0; j < 16; ++j) { const unsigned c = xb_ld(&bar[XB_XCNT(j)]); sum += c; cnt += (c > 0u) ? 1u : 0u; mine = (j == x) ? c : mine; }
        if (sum == G) break;
        __builtin_amdgcn_s_sleep(1);
        if ((++sp & 255u) == 0u) { if (xb_ld(&bar[XB_TMO])) break; if (sp > XB_SPIN_CAP) { atomicAdd(&bar[XB_TMO], 1u); break; } }
    }
    nloc = mine > 0u ? mine : 1u; nx = cnt > 0u ? cnt : 1u;
}

__device__ __forceinline__ void xcd_barrier(const XcdBarrier& b) {
    asm volatile("s_waitcnt vmcnt(0)" ::: "memory");
    __syncthreads();
    if (threadIdx.x == 0) {
        unsigned* bar = b.bar;
        __builtin_amdgcn_s_waitcnt(0);
        unsigned nloc = b.st[0], nx = b.st[1];
        if (nloc == 0u) { xcd_barrier_complete(bar, b.x, nloc, nx); b.st[0] = nloc; b.st[1] = nx; }
        const unsigned old = xb_add(&bar[XB_XSUB(b.x)], 1u);
        const unsigned gen = old / nloc;
        if (old + 1u == (gen + 1u) * nloc) {
            __builtin_amdgcn_fence(__ATOMIC_RELEASE, "agent");
            asm volatile("s_waitcnt vmcnt(0)" ::: "memory");
            const unsigned og = xb_add(&bar[XB_TOP], 1u);
            const unsigned tg = og / nx;
            if (og + 1u == (tg + 1u) * nx) xb_add(&bar[XB_TOPGEN], 1u);
            else XB_SPIN(xb_ld(&bar[XB_TOPGEN]) == tg, bar);
            __builtin_amdgcn_fence(__ATOMIC_ACQUIRE, "agent");
            xb_add(&bar[XB_XGEN(b.x)], 1u);
            asm volatile("s_waitcnt vmcnt(0)" ::: "memory");
        } else {
            XB_SPIN(xb_ld(&bar[XB_XGEN(b.x)]) == gen, bar);
            __builtin_amdgcn_fence(__ATOMIC_ACQUIRE, "agent");
            asm volatile("s_waitcnt vmcnt(0)" ::: "memory");
        }
    }
    __syncthreads();
}

__global__ void __launch_bounds__(NTHREADS, 2) mk_fwd(Args a_in) {
    extern __shared__ __attribute__((aligned(16))) unsigned char lds_raw[];
    LAS unsigned char* lds = (LAS unsigned char*)lds_raw;
    cg::grid_group grid = cg::this_grid();
    const int G = gridDim.x;
    volatile LAS unsigned* MISC = (volatile LAS unsigned*)(lds + 131072);
    if (threadIdx.x < 16) MISC[threadIdx.x] = 0u;
    __syncthreads();
    XcdBarrier bar = xcd_barrier_post((unsigned*)(a_in.ws + WS_CTL), MISC + 8);
    for (int ph = a_in.ph_lo; ph < a_in.ph_hi; ++ph) {
        ArgsP a = (ArgsP)__builtin_amdgcn_kernarg_segment_ptr(); asm volatile("" : "+s"(a));
        unsigned char* ws = a->ws;
        int bx = blockIdx.x; asm volatile("" : "+s"(bx));
        const int spid = (ph == 0) ? 12 : (ph == 49) ? 14 : (ph - 1) % 12;
        const int nrep = ((DUPM >> spid) & 1) ? 2 : 1;
#pragma unroll 1
        for (int rep = 0; rep < nrep; ++rep) {
        if (ph == 0) { if (PHM & 1) phase_prologue(a, lds); }
        else if (ph == 49) { if (PHM & 2) phase_final_norm(a); }
        else {
            const int l = (ph - 1) / 12, sp = (ph - 1) % 12;
            const float* mods = (const float*)(ws + WS_MODS) + (size_t)l * 3 * 9216;
            if (sp == 0 || sp == 3 || sp == 9) { if (PHM & 2) phase_norm(a, l, sp == 0 ? 0 : sp == 3 ? 1 : 2); }
            else if ((PHM & 4) && (sp == 1 || sp == 10)) {
                const int j = sp == 1 ? 0 : 1;
                pg8::Gemm g{(const bf16_t*)(ws + WS_XN), (const bf16_t*)(ws + WS_WGU + (size_t)(l * 2 + j) * SZ_WGU1), M, NGU, DM};
                pg8::StaticOrder S; S.init(M, NGU, G, bx);
                pg8::EpiSwiGLU E{(bf16_t*)(ws + WS_R1)};
                pg8::gemm_phase<pg8::EpiSwiGLU, pg8::StaticOrder, true, true>(lds, g, S, E);
            } else if ((PHM & 8) && (sp == 2 || sp == 11)) {
                const int j = sp == 2 ? 0 : 1;
                pg8::Gemm g{(const bf16_t*)(ws + WS_R1), (const bf16_t*)(ws + WS_WD + (size_t)(l * 2 + j) * SZ_WD1), M, DM, FF};
                pg8::StaticOrder S; S.init(M, DM, G, bx);
                pg8::EpiResid E{(const float*)(ws + WS_X), (float*)(ws + WS_X), mods + (j == 0 ? 2 : 8) * 1024, 0.5f};
                pg8::gemm_phase<pg8::EpiResid, pg8::StaticOrder, true, true>(lds, g, S, E);
            } else if ((PHM & 16) && sp == 4) {
                pg8::Gemm g{(const bf16_t*)(ws + WS_XN), (const bf16_t*)(ws + WS_WIN + (size_t)l * SZ_WIN1), M, NIN, DM};
                pg8::StaticOrder S; S.init(M, NIN, G, bx);
                pg8::EpiF32 E{(float*)(ws + WS_PROJ), NIN};
                pg8::gemm_phase<pg8::EpiF32, pg8::StaticOrder, true, true>(lds, g, S, E);
            } else if (sp == 5) { if (PHM & 32) phase_prep(a, l); }
            else if (sp == 6) {
                int k256 = 256; asm volatile("" : "+s"(k256));
                if (PHM & 64) {
                    pg8::Gemm g{(const bf16_t*)(ws + WS_R1 + R1_QLATN), (const bf16_t*)(ws + WS_WUQ + (size_t)l * SZ_WUQ1), M, 768, k256};
                    pg8::StaticOrder S; S.init(M, 768, G, bx);
                    pg8::EpiBf16S E{(bf16_t*)(ws + WS_R1 + R1_QM), 768, 0.10206207261596575f * LOG2E};
                    pg8::gemm_phase<pg8::EpiBf16S, pg8::StaticOrder, true, true>(lds, g, S, E);
                }
                if (PHM & 128) {
                    pg8::Gemm g{(const bf16_t*)(ws + WS_R1 + R1_CKV), (const bf16_t*)(ws + WS_WUKV + (size_t)l * SZ_WUKV1), KVROWS, 768, k256};
                    pg8::StaticOrder S; S.init(KVROWS, 768, G, bx);
                    pg8::EpiBf16S E{(bf16_t*)(ws + WS_R1 + R1_KVM), 768, 1.0f};
                    pg8::gemm_phase<pg8::EpiBf16S, pg8::StaticOrder, true, true>(lds, g, S, E);
                }
                if ((PHM & 256) && rep == 0) phase_mlstm_scan(a, l);
            } else if (sp == 7) { if ((PHM & 512) && (rep == 0 || !(DUPM & 8192))) phase_mlstm_out(a, l); if ((PHM & 1024) && (rep == 0 || (DUPM & 8192))) phase_attention(a, lds); }
            else if ((PHM & 2048) && sp == 8) {
                pg8::Gemm g{(const bf16_t*)(ws + WS_XN), (const bf16_t*)(ws + WS_WOUT + (size_t)l * SZ_WOUT1), M, DM, DM};
                pg8::StaticOrder S; S.init(M, DM, G, bx);
                pg8::EpiResid E{(const float*)(ws + WS_X), (float*)(ws + WS_X), mods + 5 * 1024, 1.0f};
                pg8::gemm_phase<pg8::EpiResid, pg8::StaticOrder, true, true>(lds, g, S, E);
            }
        }
        }
        if (ph + 1 < a_in.ph_hi) { if (ph == a_in.ph_lo) grid.sync(); else xcd_barrier(bar); }
#if defined(MK_XSYNC)
        for (int xs = 0; xs < MK_XSYNC; ++xs) xcd_barrier(bar);
#endif
    }
}

extern "C" void kernel_launch(void* const* d_in, const int* in_sizes, int n_in, void* d_out, int out_size, void* d_ws, size_t ws_size, hipStream_t stream) {
    static int grid = 0;
    if (grid == 0) {
        if (n_in != 28 || ws_size < WS_END) { fprintf(stderr, "kernel_launch: unexpected n_in %d or ws_size %zu (< %zu)\n", n_in, ws_size, (size_t)WS_END); grid = -1; return; }
        int dev = 0, cus = 0, per_cu = 0;
        hipGetDevice(&dev); hipDeviceGetAttribute(&cus, hipDeviceAttributeMultiprocessorCount, dev);
        hipFuncSetAttribute((const void*)mk_fwd, hipFuncAttributeMaxDynamicSharedMemorySize, LDS_BYTES);
        hipOccupancyMaxActiveBlocksPerMultiprocessor(&per_cu, (const void*)mk_fwd, NTHREADS, LDS_BYTES);
        (void)hipGetLastError();
        if (per_cu < 1) per_cu = 1;
        grid = cus;
        if (grid <= 0) grid = 256;
    }
    if (grid < 0) return;
    Args a{};
    for (int i = 0; i < 28; ++i) a.in[i] = (const float*)d_in[i];
    a.out = (float*)d_out; a.ws = (unsigned char*)d_ws;
    if (hipMemsetAsync((unsigned char*)d_ws + WS_CTL, 0, CTL_BYTES, stream) != hipSuccess) { fprintf(stderr, "kernel_launch: memset of the barrier words failed\n"); return; }
#if MK_MULTI_LAUNCH
    for (int ph = 0; ph < 50; ++ph) { a.ph_lo = ph; a.ph_hi = ph + 1; hipLaunchKernelGGL(mk_fwd, dim3(grid), dim3(NTHREADS), LDS_BYTES, stream, a); }
#else
    a.ph_lo = 0; a.ph_hi = 50;
    void* args[] = {&a};
    hipError_t e = hipLaunchCooperativeKernel((const void*)mk_fwd, dim3(grid), dim3(NTHREADS), args, LDS_BYTES, stream);
    if (e != hipSuccess) fprintf(stderr, "cooperative launch failed: %s (grid %d)\n", hipGetErrorString(e), grid);
#endif
}
```

```cpp
#include <hip/hip_runtime.h>
#include <hip/hip_cooperative_groups.h>
#include <cstdio>
#include <cstdint>
namespace cg = cooperative_groups;

#ifndef MK_MULTI_LAUNCH
#define MK_MULTI_LAUNCH 0
#endif
namespace pg8 {
#define PG8_LAS __attribute__((address_space(3)))
__device__ __forceinline__ int lt_tid() { int t = threadIdx.x; asm volatile("" : "+v"(t)); return t; }
typedef unsigned short bf16_t;
typedef short bf16x8 __attribute__((ext_vector_type(8)));
typedef float f32x4 __attribute__((ext_vector_type(4)));
typedef unsigned u32x4 __attribute__((ext_vector_type(4)));
constexpr int BM = 256, BK = 64, HALF = 128, HTB = HALF * BK * 2  , STAGE_BYTES = 8 * HTB, NXCD = 8, WGM = 8;

__host__ __device__ __forceinline__ int lds_byte(int r, int c) { const int st = (r >> 4) * 2 + (c >> 5), rr = r & 15, cc = c & 31, ob = rr * 64 + cc * 2; return st * 1024 + (ob ^ (((ob >> 9) & 1) << 5)); }
__host__ __device__ __forceinline__ void stage_rc(int b, int& R, int& C) { const int st = b / 1024, sb = b % 1024, swz = sb ^ (((sb >> 9) & 1) << 5); R = (st >> 1) * 16 + swz / 64; C = (st & 1) * 32 + (swz % 64) / 2; }
__host__ __device__ __forceinline__ int perm32(int rho) { const int n = rho >> 4, i = rho & 15; return 8 * (i >> 2) + 4 * n + (i & 3); }

struct Unit { int pm, pn; };
struct Gemm { const bf16_t* A; const bf16_t* Bt; int M, N, K; };

struct StaticOrder {
    int nM, nN, nwg, G, c;
    __host__ __device__ void init(int M, int N, int G_, int c_) { nM = M / BM; nN = N / BM; nwg = nM * nN; G = G_; c = c_; }
    __host__ __device__ bool next(int i, Unit& u) const {
        const long L = (long)i * G + c; if (L >= nwg) return false;
        int wgid = (int)L; { const int q = nwg / NXCD, r = nwg % NXCD, xcd = wgid % NXCD, off = wgid / NXCD; wgid = (xcd < r ? xcd * (q + 1) : r * (q + 1) + (xcd - r) * q) + off; }
        const int nig = WGM * nN, gid = wgid / nig, fm = gid * WGM, gsz = (nM - fm) < WGM ? (nM - fm) : WGM;
        u.pm = fm + ((wgid % nig) % gsz); u.pn = (wgid % nig) / gsz; return true;
    }
    __device__ __forceinline__ void a_ready(const Unit&) const {}
    __device__ __forceinline__ void done(const Unit&) const {}
};

__device__ __forceinline__ unsigned cvt_pk_bf16(float lo, float hi) { unsigned r; asm volatile("v_cvt_pk_bf16_f32 %0, %1, %2" : "=v"(r) : "v"(lo), "v"(hi)); return r; }
typedef float f32x2 __attribute__((ext_vector_type(2)));
typedef unsigned u32x2 __attribute__((ext_vector_type(2)));
__device__ __forceinline__ float silu_f(float x) { return x * __builtin_amdgcn_rcpf(1.0f + __expf(-x)); }

struct EpiSwiGLU {
    static constexpr bool PERM = true, AFTER_DRAIN = false;
    bf16_t* O;
    __device__ __forceinline__ void operator()(const f32x4 (&acc)[2][2][4][2], const Unit& u, int wr, int wc, int fr, int fq) const {
        const int row0 = u.pm * BM + wr * 64 + fr, col0 = u.pn * 128 + wc * 32 + 8 * fq;
#pragma unroll
        for (int ai = 0; ai < 2; ++ai)
#pragma unroll
            for (int m = 0; m < 4; ++m) {
                bf16_t* rowp = O + (size_t)(row0 + ai * HALF + m * 16) * 2816 + col0;
                const f32x4 g0 = acc[ai][0][m][0], g1 = acc[ai][0][m][1], u0 = acc[ai][1][m][0], u1 = acc[ai][1][m][1];
                u32x4 w;
                w.x = cvt_pk_bf16(silu_f(g0[0]) * u0[0], silu_f(g0[1]) * u0[1]); w.y = cvt_pk_bf16(silu_f(g0[2]) * u0[2], silu_f(g0[3]) * u0[3]);
                w.z = cvt_pk_bf16(silu_f(g1[0]) * u1[0], silu_f(g1[1]) * u1[1]); w.w = cvt_pk_bf16(silu_f(g1[2]) * u1[2], silu_f(g1[3]) * u1[3]);
                *(u32x4*)rowp = w;
            }
    }
};
struct EpiResid {
    static constexpr bool PERM = false, AFTER_DRAIN = false;
    const float* base; float* out; const float* gmod; float gs;
    __device__ __forceinline__ void operator()(const f32x4 (&acc)[2][2][4][2], const Unit& u, int wr, int wc, int fr, int fq) const {
        const int row0 = u.pm * BM + wr * 64 + fr, col0 = u.pn * BM + wc * 32 + 4 * fq;
        const int cond = u.pm < 32 ? 0 : 1 + ((u.pm - 32) >> 4);
        const float* g = gmod + cond * 9216;
#pragma unroll
        for (int bj = 0; bj < 2; ++bj)
#pragma unroll
            for (int n = 0; n < 2; ++n) {
                const f32x4 gv = *(const f32x4*)(g + col0 + bj * HALF + n * 16) * gs;
#pragma unroll
                for (int ai = 0; ai < 2; ++ai)
#pragma unroll
                    for (int m = 0; m < 4; ++m) {
                        const size_t off = (size_t)(row0 + ai * HALF + m * 16) * 1024 + col0 + bj * HALF + n * 16;
                        *(f32x4*)(out + off) = *(const f32x4*)(base + off) + gv * acc[ai][bj][m][n];
                    }
            }
    }
};
struct EpiF32 {
    static constexpr bool PERM = false, AFTER_DRAIN = false;
    float* out; int ldc;
    __device__ __forceinline__ void operator()(const f32x4 (&acc)[2][2][4][2], const Unit& u, int wr, int wc, int fr, int fq) const {
        const int row0 = u.pm * BM + wr * 64 + fr, col0 = u.pn * BM + wc * 32 + 4 * fq;
#pragma unroll
        for (int ai = 0; ai < 2; ++ai)
#pragma unroll
            for (int m = 0; m < 4; ++m)
#pragma unroll
                for (int bj = 0; bj < 2; ++bj)
#pragma unroll
                    for (int n = 0; n < 2; ++n)
                        *(f32x4*)(out + (size_t)(row0 + ai * HALF + m * 16) * ldc + col0 + bj * HALF + n * 16) = acc[ai][bj][m][n];
    }
};
struct EpiBf16S {
    static constexpr bool PERM = true, AFTER_DRAIN = false;
    bf16_t* O; int ldc; float scale;
    __device__ __forceinline__ void operator()(const f32x4 (&acc)[2][2][4][2], const Unit& u, int wr, int wc, int fr, int fq) const {
        const int row0 = u.pm * BM + wr * 64 + fr, col0 = u.pn * BM + wc * 32 + 8 * fq;
#pragma unroll
        for (int ai = 0; ai < 2; ++ai)
#pragma unroll
            for (int m = 0; m < 4; ++m) {
                bf16_t* rowp = O + (size_t)(row0 + ai * HALF + m * 16) * ldc + col0;
#pragma unroll
                for (int bj = 0; bj < 2; ++bj) {
                    const f32x4 v0 = acc[ai][bj][m][0] * scale, v1 = acc[ai][bj][m][1] * scale;
                    u32x4 w; w.x = cvt_pk_bf16(v0[0], v0[1]); w.y = cvt_pk_bf16(v0[2], v0[3]); w.z = cvt_pk_bf16(v1[0], v1[1]); w.w = cvt_pk_bf16(v1[2], v1[3]);
                    *(u32x4*)(rowp + bj * HALF) = w;
                }
            }
    }
};
template <class Epi, class Sched, bool ALIGN_EPI = false, bool SP2 = false>
__device__ __forceinline__ void gemm_phase(PG8_LAS unsigned char* lds, const Gemm g, const Sched& S, const Epi& E) {
    const int tid = lt_tid(), wid = __builtin_amdgcn_readfirstlane(tid >> 6), lane = tid & 63, wr = wid >> 2, wc = wid & 3, fr = lane & 15, fq = lane >> 4;
    const int K = g.K, nt = K / BK;
    unsigned voffA[2], voffB[2];
#pragma unroll
    for (int i = 0; i < 2; ++i) { int R, C; stage_rc(tid * 16 + i * 8192, R, C); const int Rb = Epi::PERM ? ((R & ~31) + perm32(R & 31)) : R;
        voffA[i] = (unsigned)(R * K + C) * 2u; voffB[i] = (unsigned)(Rb * K + C) * 2u; }
    const size_t kstep = (size_t)(BK * 2);
    const size_t hstep = (size_t)HALF * K * 2;
    const size_t tstep = 2 * hstep;
    const unsigned ldsw = (unsigned)wid * 1024u;
    const int aoff = lds_byte(wr * 64 + fr, fq * 8), boff = lds_byte(wc * 32 + fr, fq * 8);
#define PG8_SA(b, h) (((b) * 2 + (h)) * HTB)
#define PG8_SB(b, h) ((4 + (b) * 2 + (h)) * HTB)
#define PG8_STAGE(bufoff, gbase, voff) do { _Pragma("unroll") for (int _i = 0; _i < 2; ++_i) \
        __builtin_amdgcn_global_load_lds((const unsigned*)((const char*)(gbase) + (voff)[_i]), (PG8_LAS unsigned*)(lds + (bufoff) + ldsw + _i * 8192), 16, 0, 0); } while (0)
#define PG8_LDA(dst, b, h) do { _Pragma("unroll") for (int m = 0; m < 4; ++m) _Pragma("unroll") for (int k = 0; k < 2; ++k) dst[m][k] = *(const PG8_LAS bf16x8*)(lds + PG8_SA(b, h) + aoff + m * 2048 + k * 1024); } while (0)
#define PG8_LDB(dst, b, h) do { _Pragma("unroll") for (int n = 0; n < 2; ++n) _Pragma("unroll") for (int k = 0; k < 2; ++k) dst[n][k] = *(const PG8_LAS bf16x8*)(lds + PG8_SB(b, h) + boff + n * 2048 + k * 1024); } while (0)
#define PG8_MMA(ai, bj, At, Bt) do { __builtin_amdgcn_s_setprio(1); _Pragma("unroll") for (int m = 0; m < 4; ++m) _Pragma("unroll") for (int n = 0; n < 2; ++n) _Pragma("unroll") for (int k = 0; k < 2; ++k) \
        acc[ai][bj][m][n] = __builtin_amdgcn_mfma_f32_16x16x32_bf16(Bt[n][k], At[m][k], acc[ai][bj][m][n], 0, 0, 0); __builtin_amdgcn_s_setprio(0); } while (0)
#define PG8_WAIT_V(n) asm volatile("s_waitcnt vmcnt(" #n ")" ::: "memory")
#define PG8_WAIT_L(n) asm volatile("s_waitcnt lgkmcnt(" #n ")" ::: "memory")
#define PG8_BAR __builtin_amdgcn_s_barrier()
#define PG8_SCHED __builtin_amdgcn_sched_barrier(0)
    Unit cur, nxt; int ui = 0;
    if (!S.next(0, cur)) return;
    f32x4 acc[2][2][4][2];
#pragma unroll
    for (int a = 0; a < 2; ++a)
#pragma unroll
        for (int b = 0; b < 2; ++b)
#pragma unroll
            for (int m = 0; m < 4; ++m)
#pragma unroll
                for (int n = 0; n < 2; ++n) acc[a][b][m][n] = (f32x4){0.f, 0.f, 0.f, 0.f};
    bf16x8 At[4][2], B0[2][2], B1[2][2];
    const char* cA = (const char*)g.A + (size_t)cur.pm * tstep; const char* cB = (const char*)g.Bt + (size_t)cur.pn * tstep;
    S.a_ready(cur);
    if constexpr (SP2) {
        PG8_STAGE(PG8_SB(0, 0), cB, voffB); PG8_STAGE(PG8_SB(0, 1), cB + hstep, voffB); PG8_STAGE(PG8_SA(0, 0), cA, voffA); PG8_STAGE(PG8_SA(0, 1), cA + hstep, voffA);
        if (wr == 1) PG8_BAR;
        PG8_WAIT_V(2); PG8_BAR;
        PG8_STAGE(PG8_SB(1, 0), cB + kstep, voffB); PG8_STAGE(PG8_SA(1, 0), cA + kstep, voffA); PG8_STAGE(PG8_SB(1, 1), cB + hstep + kstep, voffB);
        PG8_WAIT_V(6); PG8_BAR;
    } else {
        PG8_STAGE(PG8_SB(0, 0), cB, voffB); PG8_STAGE(PG8_SA(0, 0), cA, voffA); PG8_STAGE(PG8_SB(0, 1), cB + hstep, voffB); PG8_STAGE(PG8_SA(0, 1), cA + hstep, voffA);
        if (wr == 1) PG8_BAR;
        PG8_WAIT_V(4); PG8_BAR;
        PG8_STAGE(PG8_SB(1, 0), cB + kstep, voffB); PG8_STAGE(PG8_SA(1, 0), cA + kstep, voffA); PG8_STAGE(PG8_SB(1, 1), cB + hstep + kstep, voffB);
        PG8_WAIT_V(6); PG8_BAR;
    }
    for (;;) {
        const bool has_next = S.next(ui + 1, nxt);
        const char* nA = has_next ? (const char*)g.A + (size_t)nxt.pm * tstep : cA; const char* nB = has_next ? (const char*)g.Bt + (size_t)nxt.pn * tstep : cB;
        for (int t = 0; t < nt; t += 2) {
            const bool last = (t == nt - 2);
            const char* a1 = cA + (size_t)(t + 1) * kstep;
            const char* a2 = last ? nA : cA + (size_t)(t + 2) * kstep; const char* b2 = last ? nB : cB + (size_t)(t + 2) * kstep;
            const char* a3 = a2 + kstep; const char* b3 = b2 + kstep;
            if (last && has_next) S.a_ready(nxt);
            if constexpr (SP2) {
            PG8_LDB(B0, 0, 0); PG8_LDB(B1, 0, 1); PG8_SCHED; PG8_LDA(At, 0, 0); PG8_STAGE(PG8_SA(1, 1), a1 + hstep, voffA);
            PG8_WAIT_V(8); PG8_WAIT_L(0); PG8_BAR; PG8_MMA(0, 0, At, B0); PG8_MMA(0, 1, At, B1); PG8_BAR; PG8_SCHED;
            PG8_LDA(At, 0, 1); PG8_STAGE(PG8_SB(0, 0), b2, voffB); PG8_STAGE(PG8_SB(0, 1), b2 + hstep, voffB); PG8_STAGE(PG8_SA(0, 0), a2, voffA);
            PG8_WAIT_V(8); PG8_WAIT_L(0); PG8_BAR; PG8_MMA(1, 0, At, B0); PG8_MMA(1, 1, At, B1); PG8_BAR; PG8_SCHED;
            PG8_LDB(B0, 1, 0); PG8_LDB(B1, 1, 1); PG8_SCHED; PG8_LDA(At, 1, 0); PG8_STAGE(PG8_SA(0, 1), a2 + hstep, voffA);
            PG8_WAIT_V(8); PG8_WAIT_L(0); PG8_BAR; PG8_MMA(0, 0, At, B0); PG8_MMA(0, 1, At, B1); PG8_BAR; PG8_SCHED;
            PG8_LDA(At, 1, 1); PG8_STAGE(PG8_SB(1, 0), b3, voffB); PG8_STAGE(PG8_SB(1, 1), b3 + hstep, voffB); PG8_STAGE(PG8_SA(1, 0), a3, voffA);
            PG8_WAIT_V(8); PG8_WAIT_L(0); PG8_BAR; PG8_MMA(1, 0, At, B0); PG8_MMA(1, 1, At, B1); PG8_BAR; PG8_SCHED;
            } else {
            PG8_LDB(B0, 0, 0); PG8_SCHED; PG8_LDA(At, 0, 0); PG8_STAGE(PG8_SA(1, 1), a1 + hstep, voffA);
            PG8_WAIT_L(8); PG8_BAR; PG8_WAIT_L(0); PG8_MMA(0, 0, At, B0); PG8_BAR; PG8_SCHED;
            PG8_LDB(B1, 0, 1); PG8_STAGE(PG8_SB(0, 0), b2, voffB);
            PG8_BAR; PG8_WAIT_L(0); PG8_MMA(0, 1, At, B1); PG8_BAR;
            PG8_LDA(At, 0, 1); PG8_STAGE(PG8_SA(0, 0), a2, voffA);
            PG8_BAR; PG8_WAIT_L(0); PG8_MMA(1, 0, At, B0); PG8_BAR; PG8_SCHED;
            PG8_STAGE(PG8_SB(0, 1), b2 + hstep, voffB);
            PG8_WAIT_V(6); PG8_BAR; PG8_MMA(1, 1, At, B1); PG8_BAR;
            PG8_LDB(B0, 1, 0); PG8_SCHED; PG8_LDA(At, 1, 0); PG8_STAGE(PG8_SA(0, 1), a2 + hstep, voffA);
            PG8_WAIT_L(8); PG8_BAR; PG8_WAIT_L(0); PG8_MMA(0, 0, At, B0); PG8_BAR; PG8_SCHED;
            PG8_LDB(B1, 1, 1); PG8_STAGE(PG8_SB(1, 0), b3, voffB);
            PG8_BAR; PG8_WAIT_L(0); PG8_MMA(0, 1, At, B1); PG8_BAR;
            PG8_LDA(At, 1, 1); PG8_STAGE(PG8_SA(1, 0), a3, voffA);
            PG8_BAR; PG8_WAIT_L(0); PG8_MMA(1, 0, At, B0); PG8_BAR; PG8_SCHED;
            PG8_STAGE(PG8_SB(1, 1), b3 + hstep, voffB);
            PG8_WAIT_V(6); PG8_BAR; PG8_MMA(1, 1, At, B1); PG8_BAR;
            }
        }
        if constexpr (ALIGN_EPI) { if (wr == 0) PG8_BAR; }
        if constexpr (!Epi::AFTER_DRAIN) { E(acc, cur, wr, wc, fr, fq); S.done(cur); }
        if (!has_next) break;
#pragma unroll
        for (int a = 0; a < 2; ++a)
#pragma unroll
            for (int b = 0; b < 2; ++b)
#pragma unroll
                for (int m = 0; m < 4; ++m)
#pragma unroll
                    for (int n = 0; n < 2; ++n) acc[a][b][m][n] = (f32x4){0.f, 0.f, 0.f, 0.f};
        cur = nxt; cA = nA; cB = nB; ++ui;
        if constexpr (ALIGN_EPI) { if (wr == 1) PG8_BAR; }
    }
    PG8_WAIT_V(0);
    if constexpr (!ALIGN_EPI) { if (wr == 0) PG8_BAR; }
    PG8_BAR;
    if constexpr (Epi::AFTER_DRAIN) { E.fused(acc, cur, wr, wc, fr, fq, lds, wid, lane); S.done(cur); }
#undef PG8_SA
#undef PG8_SB
#undef PG8_STAGE
#undef PG8_LDA
#undef PG8_LDB
#undef PG8_MMA
#undef PG8_WAIT_V
#undef PG8_WAIT_L
#undef PG8_BAR
#undef PG8_SCHED
}
}
#define LAS __attribute__((address_space(3)))
typedef unsigned short bf16_t;
typedef short bf16x8 __attribute__((ext_vector_type(8)));
typedef short s16x4 __attribute__((ext_vector_type(4)));
typedef float f32x4 __attribute__((ext_vector_type(4)));
typedef float f32x16 __attribute__((ext_vector_type(16)));
typedef unsigned u32x4 __attribute__((ext_vector_type(4)));
typedef unsigned u32x2 __attribute__((ext_vector_type(2)));
using pg8::cvt_pk_bf16;

#ifndef MK_PHM
#define MK_PHM 0xFFFF
#endif
constexpr int PHM = MK_PHM;
#ifndef MK_DUPM
#define MK_DUPM 0
#endif
constexpr int DUPM = MK_DUPM;
constexpr int NTHREADS = 512, NWAVES = 8;
constexpr int M = 16384, MCTX = 8192, DM = 1024, FF = 2816, NGU = 2 * FF, DIN = 2224, NIN = 2304, KVROWS = 16896, NLAYER = 4;
constexpr float EPS = 1e-6f, LOG2E = 1.4426950408889634f;
constexpr int LDS_BYTES = 8 * 17408 + 1024;

constexpr size_t al256(size_t x) { return (x + 255) & ~(size_t)255; }
constexpr size_t SZ_WGU1 = (size_t)NGU * DM * 2, SZ_WD1 = (size_t)DM * FF * 2, SZ_WIN1 = (size_t)NIN * DM * 2, SZ_WOUT1 = (size_t)DM * DM * 2, SZ_WUQ1 = (size_t)768 * 256 * 2, SZ_WUKV1 = (size_t)768 * 256 * 2;
constexpr size_t WS_WGU = 0;
constexpr size_t WS_WD = WS_WGU + 8 * SZ_WGU1;
constexpr size_t WS_WIN = WS_WD + 8 * SZ_WD1;
constexpr size_t WS_WOUT = WS_WIN + 4 * SZ_WIN1;
constexpr size_t WS_WUQ = WS_WOUT + 4 * SZ_WOUT1;
constexpr size_t WS_WUKV = WS_WUQ + 4 * SZ_WUQ1;
constexpr size_t WS_MODS = WS_WUKV + 4 * SZ_WUKV1;
constexpr size_t WS_ROPE64 = WS_MODS + al256((size_t)4 * 3 * 9216 * 4);
constexpr size_t WS_ROPE32 = WS_ROPE64 + (size_t)4096 * 64 * 4;
constexpr size_t WS_X = WS_ROPE32 + (size_t)4096 * 32 * 4;
constexpr size_t WS_XN = WS_X + (size_t)M * DM * 4;
constexpr size_t WS_R1 = WS_XN + (size_t)M * DM * 2;
constexpr size_t SZ_R1 = (size_t)M * FF * 2;
constexpr size_t WS_PROJ = WS_R1 + SZ_R1;
constexpr size_t WS_MLA = WS_PROJ + (size_t)M * NIN * 4;
constexpr size_t WS_MLN = WS_MLA + (size_t)2048 * 4096 * 4;
constexpr size_t WS_MLS = WS_MLN + (size_t)2048 * 64 * 4;
constexpr size_t WS_CTL = WS_MLS + (size_t)2048 * 4 * 4;
constexpr size_t CTL_BYTES = 16384;
constexpr size_t WS_END = WS_CTL + CTL_BYTES;
constexpr size_t R1_QG = 0;
constexpr size_t R1_KG = R1_QG + (size_t)M * 384 * 2;
constexpr size_t R1_VG = R1_KG + (size_t)KVROWS * 128 * 2;
constexpr size_t R1_QLATN = R1_VG + (size_t)KVROWS * 128 * 2;
constexpr size_t R1_CKV = R1_QLATN + (size_t)M * 256 * 2;
constexpr size_t R1_KROPE = R1_CKV + (size_t)KVROWS * 256 * 2;
constexpr size_t R1_QM = R1_KROPE + (size_t)KVROWS * 32 * 2;
constexpr size_t R1_KVM = R1_QM + (size_t)M * 768 * 2;
constexpr size_t R1_END = R1_KVM + (size_t)KVROWS * 768 * 2;
static_assert(R1_END <= SZ_R1, "mixer overlay fits in the ACT region");
static_assert(R1_KG % 256 == 0 && R1_VG % 256 == 0 && R1_QLATN % 256 == 0 && R1_CKV % 256 == 0 && R1_KROPE % 256 == 0 && R1_QM % 256 == 0 && R1_KVM % 256 == 0, "alignment");
static_assert(WS_MODS % 256 == 0 && WS_X % 256 == 0 && WS_R1 % 256 == 0 && WS_PROJ % 256 == 0, "alignment");

constexpr size_t O_YP = 0, O_YS = 8388608, O_GK = 16777216, O_GV = 20971520, O_CKV = 25165824, O_KR = 33554432, O_C = 34603008, O_N = 38797312, O_MM = 38862848;
constexpr int C_GQ = 0, C_GK = 384, C_GV = 512, C_MQ = 640, C_MK = 896, C_MV = 1152, C_MO = 1408, C_MG = 1664, C_QLAT = 1680, C_KVLAT = 1936, C_KROPE = 2192;

struct Args { const float* in[28]; float* out; unsigned char* ws; int ph_lo, ph_hi; };
typedef const __attribute__((address_space(4))) Args* ArgsP;

__device__ __forceinline__ float wave_sum(float v) {
#pragma unroll
    for (int o = 1; o < 64; o <<= 1) v += __shfl_xor(v, o);
    return v;
}
__device__ __forceinline__ float wave_max(float v) {
#pragma unroll
    for (int o = 1; o < 64; o <<= 1) v = fmaxf(v, __shfl_xor(v, o));
    return v;
}
__device__ __forceinline__ unsigned short bf1(float v) { return (unsigned short)(cvt_pk_bf16(v, 0.f) & 0xffffu); }
__device__ __forceinline__ int crow(int r, int hi) { return (r & 3) + 8 * (r >> 2) + 4 * hi; }
__device__ __forceinline__ float log_sigmoid(float x) { return fminf(x, 0.f) - log1pf(__expf(-fabsf(x))); }
__device__ __forceinline__ float scan_sum(float v, int lane) {
#pragma unroll
    for (int o = 1; o < 64; o <<= 1) { const float t = __shfl_up(v, o); if (lane >= o) v += t; }
    return v;
}
__device__ __forceinline__ float scan_max(float v, int lane) {
#pragma unroll
    for (int o = 1; o < 64; o <<= 1) { const float t = __shfl_up(v, o); if (lane >= o) v = fmaxf(v, t); }
    return v;
}

__device__ __forceinline__ void transpose_item(const float* W, int K, int N, bf16_t* WT, int dst_row0, int k0, int n0, LAS float* scr, int lane) {
    const int c4 = (lane & 15) * 4, rr = lane >> 4;
    const bool inb = (n0 + c4) < N;
    const float* src = W + (size_t)(k0 + rr) * N + n0 + c4;
#pragma unroll 8
    for (int i = 0; i < 16; ++i) {
        const f32x4 v = inb ? *(const f32x4*)(src + (size_t)(4 * i) * N) : f32x4{0.f, 0.f, 0.f, 0.f};
        *(LAS f32x4*)(scr + (4 * i + rr) * 68 + c4) = v;
    }
    asm volatile("s_waitcnt lgkmcnt(0)" ::: "memory");
    const int c = lane & 7;
#pragma unroll
    for (int j = 0; j < 8; ++j) {
        const int n = (lane >> 3) + 8 * j; const LAS float* sp = scr + (8 * c) * 68 + n;
        u32x4 o; o.x = cvt_pk_bf16(sp[0 * 68], sp[1 * 68]); o.y = cvt_pk_bf16(sp[2 * 68], sp[3 * 68]); o.z = cvt_pk_bf16(sp[4 * 68], sp[5 * 68]); o.w = cvt_pk_bf16(sp[6 * 68], sp[7 * 68]);
        *(u32x4*)(WT + (size_t)(dst_row0 + n) * K + k0 + 8 * c) = o;
    }
    asm volatile("s_waitcnt lgkmcnt(0)" ::: "memory");
}
__device__ __forceinline__ void sincos_f(float x, float& s, float& c) {
    const float k = __builtin_rintf(x * 0.63661977236758134308f);
    float r = __builtin_fmaf(-k, 1.5703125f, x); r = __builtin_fmaf(-k, 4.837512969970703125e-4f, r); r = __builtin_fmaf(-k, 7.54978995489188e-8f, r);
    const float r2 = r * r;
    float sp = 2.7557319e-6f; sp = sp * r2 - 1.9841270e-4f; sp = sp * r2 + 8.3333333e-3f; sp = sp * r2 - 1.6666667e-1f; sp = sp * r2 * r + r;
    float cp = 2.4801587e-5f; cp = cp * r2 - 1.3888889e-3f; cp = cp * r2 + 4.1666667e-2f; cp = cp * r2 - 0.5f; cp = cp * r2 + 1.0f;
    const int q = ((int)k) & 3;
    s = (q == 0) ? sp : (q == 1) ? cp : (q == 2) ? -sp : -cp;
    c = (q == 0) ? cp : (q == 1) ? -sp : (q == 2) ? -cp : sp;
}
__device__ __forceinline__ float rope_freq16(int fi) {
    const int a = fi & 3, b = fi >> 2;
    const float f = (a == 0) ? 1.0f : (a == 1) ? 0.56234132519034908f : (a == 2) ? 0.31622776601683794f : 0.17782794100389228f;
    const float g = (b == 0) ? 1.0f : (b == 1) ? 0.1f : (b == 2) ? 0.01f : 0.001f;
    return f * g;
}
struct TDesc { int in_idx, K, N, nb, mode, items; unsigned long long ws_off, dst_bytes; };
__device__ const TDesc TD[7] = {
    {14, 1024, 2816, 44, 1, 8 * 16 * 44, WS_WGU, SZ_WGU1},
    {15, 1024, 2816, 44, 2, 8 * 16 * 44, WS_WGU, SZ_WGU1},
    {16, 2816, 1024, 16, 0, 8 * 44 * 16, WS_WD, SZ_WD1},
    {17, 1024, 2224, 36, 0, 4 * 16 * 36, WS_WIN, SZ_WIN1},
    {26, 1024, 1024, 16, 0, 4 * 16 * 16, WS_WOUT, SZ_WOUT1},
    {23, 256, 576, 12, 0, 4 * 4 * 12, WS_WUQ, SZ_WUQ1},
    {25, 256, 768, 12, 0, 4 * 4 * 12, WS_WUKV, SZ_WUKV1}};
__device__ __forceinline__ void phase_prologue(ArgsP a, LAS unsigned char* lds) {
    const int tid = pg8::lt_tid(), lane = tid & 63, wave = tid >> 6;
    const int G = gridDim.x, gw = blockIdx.x * NWAVES + wave, NGW = G * NWAVES;
    unsigned char* ws = a->ws;
    {
        LAS float* scr = (LAS float*)(lds + wave * 17408);
        int total = 0;
#pragma unroll 1
        for (int d = 0; d < 7; ++d) total += TD[d].items;
#pragma unroll 1
        for (int it = gw; it < total; it += NGW) {
            int d = 0, r = it;
#pragma unroll 1
            while (r >= TD[d].items) { r -= TD[d].items; ++d; }
            const int K = TD[d].K, N = TD[d].N, nb = TD[d].nb, mode = TD[d].mode, per_mat = (K >> 6) * nb;
            const int m = r / per_mat, sub = r % per_mat, kb = sub / nb, n0 = (sub % nb) * 64;
            const float* W = a->in[TD[d].in_idx] + (size_t)m * K * N;
            bf16_t* WT = (bf16_t*)(ws + TD[d].ws_off + (size_t)m * TD[d].dst_bytes);
            const int drow = mode == 0 ? n0 : (n0 >> 7) * 256 + (mode == 2 ? 128 : 0) + (n0 & 127);
            transpose_item(W, K, N, WT, drow, kb * 64, n0, scr, lane);
        }
    }
    __syncthreads();
    {
        LAS float* sc = (LAS float*)lds;
        LAS float* red = (LAS float*)(lds + 12288);
        for (int i = tid; i < 3072; i += NTHREADS) { const int cd = i >> 10, k = i & 1023; const float v = (cd == 0) ? a->in[10][k] : a->in[2][(cd - 1) * 1024 + k]; sc[i] = v / (1.0f + __expf(-v)); }
        __syncthreads();
        float* mods = (float*)(ws + WS_MODS);
        const int kp = tid >> 5, cg4 = (tid & 31) * 4;
        for (int it = blockIdx.x; it < NLAYER * 72; it += G) {
            const int l = it / 72, n0 = (it % 72) * 128;
            const float* W = a->in[11] + (size_t)l * DM * 9216 + n0 + cg4;
            f32x4 a0 = f32x4{0.f, 0.f, 0.f, 0.f}, a1 = a0, a2 = a0;
#pragma unroll 8
            for (int k = kp * 64; k < kp * 64 + 64; ++k) { const f32x4 w = *(const f32x4*)(W + (size_t)k * 9216); a0 += w * sc[k]; a1 += w * sc[1024 + k]; a2 += w * sc[2048 + k]; }
            *(LAS f32x4*)(red + (kp * 3 + 0) * 128 + cg4) = a0; *(LAS f32x4*)(red + (kp * 3 + 1) * 128 + cg4) = a1; *(LAS f32x4*)(red + (kp * 3 + 2) * 128 + cg4) = a2;
            __syncthreads();
            if (tid < 384) { const int cd = tid >> 7, ci = tid & 127; float sacc = a->in[12][(size_t)l * 9216 + n0 + ci];
#pragma unroll
                for (int q = 0; q < 16; ++q) sacc += red[(q * 3 + cd) * 128 + ci];
                mods[((size_t)l * 3 + cd) * 9216 + n0 + ci] = sacc; }
            __syncthreads();
        }
    }
    {
        f32x4* X = (f32x4*)(ws + WS_X);
        const f32x4* xp = (const f32x4*)a->in[0]; const f32x4* xs = (const f32x4*)a->in[1];
        const size_t half = (size_t)MCTX * DM / 4;
        for (size_t i = (size_t)blockIdx.x * NTHREADS + tid; i < half; i += (size_t)G * NTHREADS) { X[i] = xp[i]; X[half + i] = xs[i]; }
    }
    {
        float* r64 = (float*)(ws + WS_ROPE64); float* r32 = (float*)(ws + WS_ROPE32);
        for (int i = blockIdx.x * NTHREADS + tid; i < 4096 * 32 + 4096 * 16; i += G * NTHREADS) {
            if (i < 4096 * 32) { const int t = i >> 5, j = i & 31; const int pos = (j < 16) ? (t >> 6) : (t & 63); const float ang = (float)pos * rope_freq16(j & 15);
                float s, c; sincos_f(ang, s, c); r64[(size_t)t * 64 + j] = c; r64[(size_t)t * 64 + 32 + j] = s; }
            else { const int ii = i - 4096 * 32; const int t = ii >> 4, j = ii & 15; const int pos = (j < 8) ? (t >> 6) : (t & 63); const float ang = (float)pos * rope_freq16(2 * (j & 7));
                float s, c; sincos_f(ang, s, c); r32[(size_t)t * 32 + j] = c; r32[(size_t)t * 32 + 16 + j] = s; }
        }
    }
}

__device__ __forceinline__ void phase_norm(ArgsP a, int l, int which) {
    const int tid = pg8::lt_tid(), lane = tid & 63, wave = tid >> 6;
    const int gw = blockIdx.x * NWAVES + wave, NGW = gridDim.x * NWAVES;
    const float* X = (const float*)(a->ws + WS_X); bf16_t* XN = (bf16_t*)(a->ws + WS_XN);
    const float* nw = a->in[13] + (size_t)(l * 3 + which) * 1024;
    const float* mods = (const float*)(a->ws + WS_MODS) + (size_t)l * 3 * 9216;
    for (int row = gw; row < M; row += NGW) {
        const int cond = row < MCTX ? 0 : 1 + ((row - MCTX) >> 12);
        const float* sh = mods + cond * 9216 + (3 * which) * 1024; const float* sc = sh + 1024;
        const f32x4* xr = (const f32x4*)(X + (size_t)row * DM) + lane;
        f32x4 v[4]; float s = 0.f;
#pragma unroll
        for (int j = 0; j < 4; ++j) { v[j] = xr[64 * j]; s += (v[j].x * v[j].x + v[j].y * v[j].y) + (v[j].z * v[j].z + v[j].w * v[j].w); }
        const float rstd = 1.0f / sqrtf(wave_sum(s) * (1.0f / DM) + EPS);
        u32x2* o = (u32x2*)(XN + (size_t)row * DM) + lane;
#pragma unroll
        for (int j = 0; j < 4; ++j) {
            const int col = 4 * lane + 256 * j;
            const f32x4 w = *(const f32x4*)(nw + col), cs = *(const f32x4*)(sc + col), hs = *(const f32x4*)(sh + col);
            const f32x4 h = v[j] * rstd * w * (cs + 1.0f) + hs;
            u32x2 p; p.x = cvt_pk_bf16(h.x, h.y); p.y = cvt_pk_bf16(h.z, h.w); o[64 * j] = p;
        }
    }
}
__device__ __forceinline__ void phase_final_norm(ArgsP a) {
    const int tid = pg8::lt_tid(), lane = tid & 63, wave = tid >> 6;
    const int gw = blockIdx.x * NWAVES + wave, NGW = gridDim.x * NWAVES;
    const float* X = (const float*)(a->ws + WS_X); const float* nw = a->in[27];
    for (int row = gw; row < M; row += NGW) {
        const f32x4* xr = (const f32x4*)(X + (size_t)row * DM) + lane;
        f32x4 v[4]; float s = 0.f;
#pragma unroll
        for (int j = 0; j < 4; ++j) { v[j] = xr[64 * j]; s += (v[j].x * v[j].x + v[j].y * v[j].y) + (v[j].z * v[j].z + v[j].w * v[j].w); }
        const float rstd = 1.0f / sqrtf(wave_sum(s) * (1.0f / DM) + EPS);
        f32x4* o = (f32x4*)(a->out + (size_t)row * DM) + lane;
#pragma unroll
        for (int j = 0; j < 4; ++j) o[64 * j] = v[j] * rstd * *(const f32x4*)(nw + 4 * lane + 256 * j);
    }
}

__device__ __forceinline__ void phase_prep(ArgsP a, int l) {
    const int tid = pg8::lt_tid(), lane = tid & 63, wave = tid >> 6;
    const int gw = blockIdx.x * NWAVES + wave, NGW = gridDim.x * NWAVES;
    unsigned char* r1 = a->ws + WS_R1;
    bf16_t* QG = (bf16_t*)(r1 + R1_QG); bf16_t* KG = (bf16_t*)(r1 + R1_KG); bf16_t* VG = (bf16_t*)(r1 + R1_VG);
    bf16_t* QLATN = (bf16_t*)(r1 + R1_QLATN); bf16_t* CKV = (bf16_t*)(r1 + R1_CKV); bf16_t* KROPE = (bf16_t*)(r1 + R1_KROPE);
    const float* PROJ = (const float*)(a->ws + WS_PROJ);
    const float* R64 = (const float*)(a->ws + WS_ROPE64); const float* R32 = (const float*)(a->ws + WS_ROPE32);
    const float* qn = a->in[18] + l * 64; const float* kn = a->in[19] + l * 64;
    const float* mqn = a->in[22] + l * 256; const float* mkvn = a->in[24] + l * 256;
    const float qscale = 0.125f * LOG2E;
    for (int it = gw; it < M + 512; it += NGW) {
        if (it < M) {
            const int row = it; const bool lat = row >= MCTX;
            const int b = lat ? (row - MCTX) >> 12 : row >> 8, t = lat ? (row - MCTX) & 4095 : row & 255;
            const int kvrow = lat ? MCTX + b * 4352 + 256 + t : row;
            const float* pr = PROJ + (size_t)row * NIN;
            const size_t octx = ((size_t)(b * 4 + l) * 256 + t);
            float c64 = 0.f, s64 = 0.f;
            if (lat) { c64 = R64[(size_t)t * 64 + (lane & 31)]; s64 = R64[(size_t)t * 64 + 32 + (lane & 31)]; }
            const float qnw = qn[lane], knw = kn[lane];
#pragma unroll
            for (int h = 0; h < 6; ++h) {
                const float v = pr[C_GQ + 64 * h + lane];
                float y = v * (1.0f / sqrtf(wave_sum(v * v) * (1.0f / 64.0f) + EPS)) * qnw;
                if (lat) { const float p = __shfl_xor(y, 32); y = (lane < 32) ? (y * c64 - p * s64) : (p * s64 + y * c64); }
                QG[(size_t)row * 384 + 64 * h + lane] = bf1(y * qscale);
            }
#pragma unroll
            for (int kvh = 0; kvh < 2; ++kvh) {
                const float v = pr[C_GK + 64 * kvh + lane];
                float y = v * (1.0f / sqrtf(wave_sum(v * v) * (1.0f / 64.0f) + EPS)) * knw;
                if (!lat) a->out[O_GK + octx * 128 + 64 * kvh + lane] = y;
                else { const float p = __shfl_xor(y, 32); y = (lane < 32) ? (y * c64 - p * s64) : (p * s64 + y * c64); }
                KG[(size_t)kvrow * 128 + 64 * kvh + lane] = bf1(y);
                const float vv = pr[C_GV + 64 * kvh + lane];
                if (!lat) a->out[O_GV + octx * 128 + 64 * kvh + lane] = vv;
                VG[(size_t)kvrow * 128 + 64 * kvh + lane] = bf1(vv);
            }
            {
                const f32x4 v = *(const f32x4*)(pr + C_QLAT + 4 * lane);
                const float rstd = 1.0f / sqrtf(wave_sum((v.x * v.x + v.y * v.y) + (v.z * v.z + v.w * v.w)) * (1.0f / 256.0f) + EPS);
                const f32x4 y = v * rstd * *(const f32x4*)(mqn + 4 * lane);
                u32x2 p; p.x = cvt_pk_bf16(y.x, y.y); p.y = cvt_pk_bf16(y.z, y.w); *(u32x2*)(QLATN + (size_t)row * 256 + 4 * lane) = p;
            }
            {
                const f32x4 v = *(const f32x4*)(pr + C_KVLAT + 4 * lane);
                const float rstd = 1.0f / sqrtf(wave_sum((v.x * v.x + v.y * v.y) + (v.z * v.z + v.w * v.w)) * (1.0f / 256.0f) + EPS);
                const f32x4 y = v * rstd * *(const f32x4*)(mkvn + 4 * lane);
                if (!lat) *(f32x4*)(a->out + O_CKV + octx * 256 + 4 * lane) = y;
                u32x2 p; p.x = cvt_pk_bf16(y.x, y.y); p.y = cvt_pk_bf16(y.z, y.w); *(u32x2*)(CKV + (size_t)kvrow * 256 + 4 * lane) = p;
            }
            {
                float v = pr[C_KROPE + (lane & 31)];
                if (!lat) { if (lane < 32) a->out[O_KR + octx * 32 + lane] = v; }
                else { const float c = R32[(size_t)t * 32 + (lane & 15)], s = R32[(size_t)t * 32 + 16 + (lane & 15)]; const float p = __shfl_xor(v, 16); v = (lane & 16) ? (p * s + v * c) : (v * c - p * s); }
                if (lane < 32) KROPE[(size_t)kvrow * 32 + lane] = bf1(v);
            }
        } else {
            const int idx = it - M, b = idx >> 8, s = idx & 255; const int kvrow = MCTX + b * 4352 + s;
            const size_t crow_ = (size_t)(b * 4 + l) * 256 + s;
            const float* ck = a->in[3] + crow_ * 128; const float* cv = a->in[4] + crow_ * 128;
#pragma unroll
            for (int kvh = 0; kvh < 2; ++kvh) {
                KG[(size_t)kvrow * 128 + 64 * kvh + lane] = bf1(ck[64 * kvh + lane]);
                VG[(size_t)kvrow * 128 + 64 * kvh + lane] = bf1(cv[64 * kvh + lane]);
            }
            const f32x4 y = *(const f32x4*)(a->in[5] + crow_ * 256 + 4 * lane);
            u32x2 p; p.x = cvt_pk_bf16(y.x, y.y); p.y = cvt_pk_bf16(y.z, y.w); *(u32x2*)(CKV + (size_t)kvrow * 256 + 4 * lane) = p;
            if (lane < 32) KROPE[(size_t)kvrow * 32 + lane] = bf1(a->in[6][crow_ * 32 + lane]);
        }
    }
    {
        float* LA = (float*)(a->ws + WS_MLA); float* LN = (float*)(a->ws + WS_MLN); float* LS = (float*)(a->ws + WS_MLS);
        const float* gb = a->in[20] + l * 16;
        const int hi = lane >> 5, l31 = lane & 31;
        for (int u = gw; u < 2048; u += NGW) {
            int h, d, c, rowbase;
            if (u < 1024) { const int bb = u >> 5; h = (u >> 3) & 3; d = (u >> 2) & 1; c = u & 3; rowbase = bb * 256; }
            else { const int v = u - 1024; const int b = v >> 9; h = (v >> 7) & 3; d = (v >> 6) & 1; c = v & 63; rowbase = MCTX + b * 4096; }
            const int r0 = rowbase + 64 * c;
            const float* pr = PROJ + (size_t)(r0 + lane) * NIN + C_MG;
            const float li = pr[(2 * d) * 4 + h] + gb[(2 * d) * 4 + h];
            const float lf = log_sigmoid(pr[(2 * d + 1) * 4 + h] + gb[(2 * d + 1) * 4 + h]);
            float bcum;
            if (d == 0) bcum = scan_sum(lf, lane); else { const float rv = __shfl(lf, 63 - lane); bcum = __shfl(scan_sum(rv, lane), 63 - lane); }
            const float bL = __shfl(bcum, d == 0 ? 63 : 0);
            const float decay = bL - bcum + li;
            const float mloc = wave_max(decay);
            const float w = __expf(decay - mloc);
            f32x16 acc[2][2];
#pragma unroll
            for (int i = 0; i < 2; ++i)
#pragma unroll
                for (int j = 0; j < 2; ++j) acc[i][j] = f32x16{};
            float nacc0 = 0.f, nacc1 = 0.f;
            const float* kbase = PROJ + (size_t)r0 * NIN + C_MK + 64 * h + l31;
            const float* vbase = PROJ + (size_t)r0 * NIN + C_MV + 64 * h + l31;
#pragma unroll 4
            for (int j = 0; j < 32; ++j) {
                const int s = 2 * j + hi;
                const float wsv = __shfl(w, s);
                const float k0 = kbase[(size_t)s * NIN] * wsv, k1 = kbase[(size_t)s * NIN + 32] * wsv;
                const float v0 = vbase[(size_t)s * NIN], v1 = vbase[(size_t)s * NIN + 32];
                acc[0][0] = __builtin_amdgcn_mfma_f32_32x32x2f32(k0, v0, acc[0][0], 0, 0, 0);
                acc[0][1] = __builtin_amdgcn_mfma_f32_32x32x2f32(k0, v1, acc[0][1], 0, 0, 0);
                acc[1][0] = __builtin_amdgcn_mfma_f32_32x32x2f32(k1, v0, acc[1][0], 0, 0, 0);
                acc[1][1] = __builtin_amdgcn_mfma_f32_32x32x2f32(k1, v1, acc[1][1], 0, 0, 0);
                nacc0 += k0; nacc1 += k1;
            }
            nacc0 += __shfl_xor(nacc0, 32); nacc1 += __shfl_xor(nacc1, 32);
            float* Au = LA + (size_t)u * 4096;
#pragma unroll
            for (int dkb = 0; dkb < 2; ++dkb)
#pragma unroll
                for (int dvb = 0; dvb < 2; ++dvb)
#pragma unroll
                    for (int r = 0; r < 16; ++r) Au[(32 * dkb + crow(r, hi)) * 64 + 32 * dvb + l31] = acc[dkb][dvb][r];
            if (hi == 0) { LN[(size_t)u * 64 + l31] = nacc0; LN[(size_t)u * 64 + 32 + l31] = nacc1; }
            if (lane == 0) { LS[(size_t)u * 4 + 0] = bL; LS[(size_t)u * 4 + 1] = mloc; }
        }
    }
}

__device__ __forceinline__ void mlstm_scan_chain(ArgsP a, int l, int chain_is_lat, int chain, int e) {
    float* LA = (float*)(a->ws + WS_MLA); float* LN = (float*)(a->ws + WS_MLN); float* LS = (float*)(a->ws + WS_MLS);
    float C, n = 0.f, m; int nc, ubase; const int d = chain & 1, h = (chain >> 1) & 3, bb = chain >> 3;
    if (chain_is_lat) {
        const size_t sidx = ((size_t)(bb * 4 + l) * 2 + d) * 4 + h;
        C = a->in[7][sidx * 4096 + e]; if (e < 64) n = a->in[8][sidx * 64 + e]; m = a->in[9][sidx];
        nc = 64; ubase = 1024 + chain * 64;
    } else { C = 0.f; m = 0.f; nc = 4; ubase = chain * 4; }
#pragma unroll 1
    for (int s0 = 0; s0 < nc; s0 += 4) {
        float bLv[4], mlv[4], av[4], anv[4];
#pragma unroll
        for (int i = 0; i < 4; ++i) {
            const int c = d == 0 ? s0 + i : nc - 1 - (s0 + i); const size_t u = (size_t)(ubase + c);
            bLv[i] = LS[u * 4 + 0]; mlv[i] = LS[u * 4 + 1]; av[i] = LA[u * 4096 + e]; anv[i] = (e < 64) ? LN[u * 64 + e] : 0.f;
        }
#pragma unroll
        for (int i = 0; i < 4; ++i) {
            const int c = d == 0 ? s0 + i : nc - 1 - (s0 + i); const size_t u = (size_t)(ubase + c);
            LA[u * 4096 + e] = C; if (e < 64) LN[u * 64 + e] = n; if (e == 0) LS[u * 4 + 2] = m;
            const float mnew = fmaxf(bLv[i] + m, mlv[i]);
            const float wold = __expf(bLv[i] + m - mnew), wloc = __expf(mlv[i] - mnew);
            C = wold * C + wloc * av[i]; n = wold * n + wloc * anv[i]; m = mnew;
        }
    }
    if (!chain_is_lat) {
        const size_t sidx = ((size_t)(bb * 4 + l) * 2 + d) * 4 + h;
        a->out[O_C + sidx * 4096 + e] = C; if (e < 64) a->out[O_N + sidx * 64 + e] = n; if (e == 0) a->out[O_MM + sidx] = m;
    }
}
__device__ __forceinline__ void phase_mlstm_scan(ArgsP a, int l) {
    int bxl = blockIdx.x; asm volatile("" : "+s"(bxl));
    const int NT = gridDim.x * NTHREADS, gt = bxl * NTHREADS + pg8::lt_tid();
    constexpr int NLAT = 16 * 4096, NCTX = 256 * 4096;
    for (int task = gt; task < NLAT; task += NT) mlstm_scan_chain(a, l, 1, task >> 12, task & 4095);
    if (NT > NLAT) { if (gt >= NLAT) for (int k = gt - NLAT; k < NCTX; k += NT - NLAT) mlstm_scan_chain(a, l, 0, k >> 12, k & 4095); }
    else for (int k = gt; k < NCTX; k += NT) mlstm_scan_chain(a, l, 0, k >> 12, k & 4095);
}

__device__ __forceinline__ void phase_mlstm_out(ArgsP a, int l) {
    const int tid = pg8::lt_tid(), lane = tid & 63, wave = tid >> 6, hi = lane >> 5, l31 = lane & 31;
    const int G = gridDim.x;
    const float* PROJ = (const float*)(a->ws + WS_PROJ);
    const float* LA = (const float*)(a->ws + WS_MLA); const float* LN = (const float*)(a->ws + WS_MLN); const float* LS = (const float*)(a->ws + WS_MLS);
    bf16_t* CAT = (bf16_t*)(a->ws + WS_XN);
    const float* gb = a->in[20] + l * 16; const float* onw = a->in[21] + l * 256;
    for (int item = wave * G + blockIdx.x; item < 2048; item += NWAVES * G) {
        const int u2 = item >> 1, tb = item & 1;
        int h, c, rowbase, ul0, ulstride;
        if (u2 < 512) { const int bb = u2 >> 4; h = (u2 >> 2) & 3; c = u2 & 3; rowbase = bb * 256; ul0 = ((bb * 4 + h) * 2) * 4 + c; ulstride = 4; }
        else { const int v = u2 - 512; const int b = v >> 8; h = (v >> 6) & 3; c = v & 63; rowbase = MCTX + b * 4096; ul0 = 1024 + ((b * 4 + h) * 2) * 64 + c; ulstride = 64; }
        const int r0 = rowbase + 64 * c;
        const float* prg = PROJ + (size_t)(r0 + lane) * NIN + C_MG;
        {
            const int tau = 32 * tb + l31;
            f32x16 hsum[2]; hsum[0] = f32x16{}; hsum[1] = f32x16{};
#pragma unroll 1
            for (int d = 0; d < 2; ++d) {
                const size_t ul = (size_t)(ul0 + d * ulstride);
                const float m_in = LS[ul * 4 + 2];
                const float* Cin = LA + ul * 4096; const float* nin = LN + ul * 64;
                const float li = prg[(2 * d) * 4 + h] + gb[(2 * d) * 4 + h];
                const float lf = log_sigmoid(prg[(2 * d + 1) * 4 + h] + gb[(2 * d + 1) * 4 + h]);
                float bcum, pm;
                if (d == 0) { bcum = scan_sum(lf, lane); pm = scan_max(li - bcum, lane); }
                else { const float rv = __shfl(lf, 63 - lane); bcum = __shfl(scan_sum(rv, lane), 63 - lane); const float ru = __shfl(li - bcum, 63 - lane); pm = __shfl(scan_max(ru, lane), 63 - lane); }
                const float uu = li - bcum;
                const float Mx = fmaxf(m_in, pm);
                const float M_t = __shfl(Mx, tau), b_t = __shfl(bcum, tau);
                const float winter = __expf(m_in - M_t);
                const float* qrow = PROJ + (size_t)(r0 + tau) * NIN + C_MQ + 64 * h + 32 * hi;
                float qn = 0.f;
#pragma unroll 1
                for (int j = 0; j < 8; ++j) { const f32x4 q4 = *(const f32x4*)(qrow + 4 * j), n4 = *(const f32x4*)(nin + 32 * hi + 4 * j); qn += (q4.x * n4.x + q4.y * n4.y) + (q4.z * n4.z + q4.w * n4.w); }
                qn = (qn + __shfl_xor(qn, 32)) * 0.125f;
                f32x16 o[2]; o[0] = f32x16{}; o[1] = f32x16{};
                float densum = 0.f;
                const float qsc = 0.125f * winter;
                {
                    const float* cbase = Cin + (size_t)(32 * hi) * 64 + l31;
#pragma unroll 1
                    for (int j = 0; j < 8; ++j) {
                        const f32x4 q4 = *(const f32x4*)(qrow + 4 * j) * qsc;
                        const float* cp = cbase + (size_t)(4 * j) * 64;
#pragma unroll
                        for (int i = 0; i < 4; ++i) {
                            o[0] = __builtin_amdgcn_mfma_f32_32x32x2f32(cp[i * 64], q4[i], o[0], 0, 0, 0);
                            o[1] = __builtin_amdgcn_mfma_f32_32x32x2f32(cp[i * 64 + 32], q4[i], o[1], 0, 0, 0);
                        }
                    }
                }
#pragma unroll 1
                for (int sb = 0; sb < 2; ++sb) {
                    const bool act = (d == 0) ? (sb <= tb) : (sb >= tb);
                    if (act) {
                        f32x16 p = f32x16{};
                        const float* krow = PROJ + (size_t)(r0 + 32 * sb + l31) * NIN + C_MK + 64 * h + 32 * hi;
#pragma unroll 1
                        for (int j = 0; j < 8; ++j) {
                            const f32x4 k4 = *(const f32x4*)(krow + 4 * j), q4 = *(const f32x4*)(qrow + 4 * j) * 0.125f;
#pragma unroll
                            for (int i = 0; i < 4; ++i) p = __builtin_amdgcn_mfma_f32_32x32x2f32(k4[i], q4[i], p, 0, 0, 0);
                        }
                        const float* vb0 = PROJ + (size_t)(r0 + 32 * sb + 4 * hi) * NIN + C_MV + 64 * h + l31;
#pragma unroll
                        for (int r = 0; r < 16; ++r) {
                            const int s = 32 * sb + crow(r, hi);
                            const float us = __shfl(uu, s);
                            const bool ok = (d == 0) ? (s <= tau) : (s >= tau);
                            const float pv = ok ? p[r] * __expf(us - M_t) : 0.f;
                            densum += pv;
                            const float* vp = vb0 + (size_t)((r & 3) + 8 * (r >> 2)) * NIN;
                            o[0] = __builtin_amdgcn_mfma_f32_32x32x2f32(vp[0], pv, o[0], 0, 0, 0);
                            o[1] = __builtin_amdgcn_mfma_f32_32x32x2f32(vp[32], pv, o[1], 0, 0, 0);
                            if ((r & 3) == 3) __builtin_amdgcn_sched_barrier(0);
                        }
                    }
                }
                densum += __shfl_xor(densum, 32);
                const float den = winter * qn + densum;
                const float dnm = fmaxf(fabsf(den), __expf(-(b_t + M_t)));
                const float inv = 1.0f / dnm;
#pragma unroll
                for (int r = 0; r < 16; ++r) { hsum[0][r] += o[0][r] * inv; hsum[1][r] += o[1][r] * inv; }
            }
            float ss = 0.f;
#pragma unroll
            for (int r = 0; r < 16; ++r) ss += hsum[0][r] * hsum[0][r] + hsum[1][r] * hsum[1][r];
            ss += __shfl_xor(ss, 32);
            const float rstd = 1.0f / sqrtf(ss * (1.0f / 64.0f) + EPS);
            const size_t row = (size_t)(r0 + tau);
            const float* mo = PROJ + row * NIN + C_MO + 64 * h;
#pragma unroll
            for (int dvb = 0; dvb < 2; ++dvb)
#pragma unroll
                for (int g = 0; g < 4; ++g) {
                    const int dv = 32 * dvb + 8 * g + 4 * hi;
                    const f32x4 og = *(const f32x4*)(mo + dv), nw4 = *(const f32x4*)(onw + 64 * h + dv);
                    float y[4];
#pragma unroll
                    for (int i = 0; i < 4; ++i) y[i] = hsum[dvb][4 * g + i] * rstd * nw4[i] * (1.0f / (1.0f + __expf(-og[i])));
                    u32x2 pk; pk.x = cvt_pk_bf16(y[0], y[1]); pk.y = cvt_pk_bf16(y[2], y[3]);
                    *(u32x2*)(CAT + row * 1024 + 384 + 64 * h + dv) = pk;
                }
        }
    }
}

template <int DQK>
__device__ __forceinline__ void attn_unit(const bf16_t* Qb, int qstride, const bf16_t* Kb, int kstride, const bf16_t* Krope, const bf16_t* Vb, int vstride, int S, bf16_t* Ob, LAS unsigned char* lds, const float* rope32, int t0) {
    constexpr int KST = DQK * 2 + 16, VST = 144, KBUF = 64 * KST, VBUF = 64 * VST, NQ = DQK / 16;
    const int tid = pg8::lt_tid(), lane = tid & 63, wave = tid >> 6, hi = lane >> 5, l31 = lane & 31;
    LAS unsigned char* Kl = lds; LAS unsigned char* Vl = lds + 2 * KBUF;
    bf16x8 q[NQ];
    { const bf16_t* qp = Qb + (size_t)(wave * 32 + l31) * qstride + 8 * hi;
#pragma unroll
      for (int i = 0; i < NQ; ++i) q[i] = *(const bf16x8*)(qp + 16 * i); }
    if constexpr (DQK == 96) {
        if (rope32) {
            const float* rp = rope32 + (size_t)(t0 + wave * 32 + l31) * 32 + 8 * hi;
            const f32x4 c0 = *(const f32x4*)(rp), c1 = *(const f32x4*)(rp + 4), s0 = *(const f32x4*)(rp + 16), s1 = *(const f32x4*)(rp + 20);
            float y1[8], y2[8];
#pragma unroll
            for (int e = 0; e < 8; ++e) {
                const float x1 = __uint_as_float(((unsigned)(unsigned short)q[4][e]) << 16), x2 = __uint_as_float(((unsigned)(unsigned short)q[5][e]) << 16);
                const float c = e < 4 ? c0[e & 3] : c1[e & 3], sn = e < 4 ? s0[e & 3] : s1[e & 3];
                y1[e] = x1 * c - x2 * sn; y2[e] = x1 * sn + x2 * c;
            }
            u32x4 w1 = u32x4{cvt_pk_bf16(y1[0], y1[1]), cvt_pk_bf16(y1[2], y1[3]), cvt_pk_bf16(y1[4], y1[5]), cvt_pk_bf16(y1[6], y1[7])};
            u32x4 w2 = u32x4{cvt_pk_bf16(y2[0], y2[1]), cvt_pk_bf16(y2[2], y2[3]), cvt_pk_bf16(y2[4], y2[5]), cvt_pk_bf16(y2[6], y2[7])};
            q[4] = __builtin_bit_cast(bf16x8, w1); q[5] = __builtin_bit_cast(bf16x8, w2);
        }
    }
    const int kkey = tid >> 3, kch = tid & 7, rkey = (tid >> 2) & 63, rch = tid & 3;
    const bf16_t* ksrc = Kb + (size_t)kkey * kstride + kch * 8;
    const bf16_t* rsrc = (DQK == 96) ? Krope + (size_t)rkey * 32 + rch * 8 : nullptr;
    const int vkey = tid & 63, vch = tid >> 6;
    const bf16_t* vsrc = Vb + (size_t)vkey * vstride + vch * 8;
    const int kdst = kkey * KST + kch * 16, rdst = rkey * KST + 128 + rch * 16, vdst = (vch * 8) * VST + vkey * 2;
    u32x4 kreg, rreg = u32x4{}, vreg;
    const int nt = S / 64;
    kreg = *(const u32x4*)ksrc; vreg = *(const u32x4*)vsrc; if (DQK == 96 && tid < 256) rreg = *(const u32x4*)rsrc;
    __syncthreads();
    *(LAS u32x4*)(Kl + kdst) = kreg; if (DQK == 96 && tid < 256) *(LAS u32x4*)(Kl + rdst) = rreg;
#define VT_STORE(buf) do { LAS unsigned short* vp_ = (LAS unsigned short*)(Vl + (buf) * VBUF + vdst); \
        vp_[0] = (unsigned short)(vreg.x & 0xffffu); vp_[VST / 2] = (unsigned short)(vreg.x >> 16); vp_[2 * (VST / 2)] = (unsigned short)(vreg.y & 0xffffu); vp_[3 * (VST / 2)] = (unsigned short)(vreg.y >> 16); \
        vp_[4 * (VST / 2)] = (unsigned short)(vreg.z & 0xffffu); vp_[5 * (VST / 2)] = (unsigned short)(vreg.z >> 16); vp_[6 * (VST / 2)] = (unsigned short)(vreg.w & 0xffffu); vp_[7 * (VST / 2)] = (unsigned short)(vreg.w >> 16); } while (0)
    VT_STORE(0);
    __syncthreads();
    float mrun = -INFINITY, lsum = 0.f;
    f32x16 o[2]; o[0] = f32x16{}; o[1] = f32x16{};
    for (int t = 0; t < nt; ++t) {
        const int cur = t & 1;
        if (t + 1 < nt) {
            kreg = *(const u32x4*)(ksrc + (size_t)(t + 1) * 64 * kstride); vreg = *(const u32x4*)(vsrc + (size_t)(t + 1) * 64 * vstride);
            if (DQK == 96 && tid < 256) rreg = *(const u32x4*)(rsrc + (size_t)(t + 1) * 64 * 32);
        }
        __builtin_amdgcn_sched_barrier(0);
        const LAS unsigned char* kb = Kl + cur * KBUF + l31 * KST + hi * 16;
        f32x16 p0 = f32x16{}, p1 = f32x16{};
#pragma unroll
        for (int i = 0; i < NQ; ++i) {
            const bf16x8 k0 = *(const LAS bf16x8*)(kb + i * 32), k1 = *(const LAS bf16x8*)(kb + 32 * KST + i * 32);
            p0 = __builtin_amdgcn_mfma_f32_32x32x16_bf16(k0, q[i], p0, 0, 0, 0);
            p1 = __builtin_amdgcn_mfma_f32_32x32x16_bf16(k1, q[i], p1, 0, 0, 0);
            if (i == 2) __builtin_amdgcn_sched_barrier(0);
        }
        __builtin_amdgcn_sched_barrier(0);
        float mx = fmaxf(p0[0], p1[0]);
#pragma unroll
        for (int r = 1; r < 16; ++r) mx = fmaxf(mx, fmaxf(p0[r], p1[r]));
        mx = fmaxf(mx, __shfl_xor(mx, 32));
        const float mnew = fmaxf(mrun, mx);
        const float alpha = __builtin_amdgcn_exp2f(mrun - mnew);
        mrun = mnew;
        float ps = 0.f;
#pragma unroll
        for (int r = 0; r < 16; ++r) { p0[r] = __builtin_amdgcn_exp2f(p0[r] - mnew); p1[r] = __builtin_amdgcn_exp2f(p1[r] - mnew); ps += p0[r] + p1[r]; }
        lsum = lsum * alpha + ps;
#pragma unroll
        for (int r = 0; r < 16; ++r) { o[0][r] *= alpha; o[1][r] *= alpha; }
        u32x4 pw[4];
        pw[0] = u32x4{cvt_pk_bf16(p0[0], p0[1]), cvt_pk_bf16(p0[2], p0[3]), cvt_pk_bf16(p0[4], p0[5]), cvt_pk_bf16(p0[6], p0[7])};
        pw[1] = u32x4{cvt_pk_bf16(p0[8], p0[9]), cvt_pk_bf16(p0[10], p0[11]), cvt_pk_bf16(p0[12], p0[13]), cvt_pk_bf16(p0[14], p0[15])};
        pw[2] = u32x4{cvt_pk_bf16(p1[0], p1[1]), cvt_pk_bf16(p1[2], p1[3]), cvt_pk_bf16(p1[4], p1[5]), cvt_pk_bf16(p1[6], p1[7])};
        pw[3] = u32x4{cvt_pk_bf16(p1[8], p1[9]), cvt_pk_bf16(p1[10], p1[11]), cvt_pk_bf16(p1[12], p1[13]), cvt_pk_bf16(p1[14], p1[15])};
        __builtin_amdgcn_sched_barrier(0);
        const LAS unsigned char* vb = Vl + cur * VBUF + l31 * VST + hi * 8;
#pragma unroll
        for (int db = 0; db < 2; ++db)
#pragma unroll
            for (int ks = 0; ks < 4; ++ks) {
                const s16x4 lo = *(const LAS s16x4*)(vb + db * 32 * VST + ks * 32), hi4 = *(const LAS s16x4*)(vb + db * 32 * VST + ks * 32 + 16);
                const bf16x8 vf = (bf16x8){lo[0], lo[1], lo[2], lo[3], hi4[0], hi4[1], hi4[2], hi4[3]};
                o[db] = __builtin_amdgcn_mfma_f32_32x32x16_bf16(vf, __builtin_bit_cast(bf16x8, pw[ks]), o[db], 0, 0, 0);
                if (ks == 3) __builtin_amdgcn_sched_barrier(0);
            }
        __builtin_amdgcn_sched_barrier(0);
        if (t + 1 < nt) {
            const int nx = cur ^ 1;
            *(LAS u32x4*)(Kl + nx * KBUF + kdst) = kreg; VT_STORE(nx); if (DQK == 96 && tid < 256) *(LAS u32x4*)(Kl + nx * KBUF + rdst) = rreg;
        }
        __syncthreads();
    }
    lsum += __shfl_xor(lsum, 32);
    const float inv = 1.0f / lsum;
    bf16_t* op = Ob + (size_t)(wave * 32 + l31) * 1024;
#pragma unroll
    for (int db = 0; db < 2; ++db)
#pragma unroll
        for (int g = 0; g < 4; ++g) {
            u32x2 pk; pk.x = cvt_pk_bf16(o[db][4 * g] * inv, o[db][4 * g + 1] * inv); pk.y = cvt_pk_bf16(o[db][4 * g + 2] * inv, o[db][4 * g + 3] * inv);
            *(u32x2*)(op + 32 * db + 8 * g + 4 * hi) = pk;
        }
#undef VT_STORE
}
__device__ __forceinline__ void phase_attention(ArgsP a, LAS unsigned char* lds) {
    unsigned char* r1 = a->ws + WS_R1;
    const bf16_t* QG = (const bf16_t*)(r1 + R1_QG); const bf16_t* KG = (const bf16_t*)(r1 + R1_KG); const bf16_t* VG = (const bf16_t*)(r1 + R1_VG);
    const bf16_t* KROPE = (const bf16_t*)(r1 + R1_KROPE); const bf16_t* QM = (const bf16_t*)(r1 + R1_QM); const bf16_t* KVM = (const bf16_t*)(r1 + R1_KVM);
    bf16_t* CAT = (bf16_t*)(a->ws + WS_XN);
    for (int ui = blockIdx.x; ui < 768; ui += gridDim.x) {
        const int kind = ui / 192, v = ui % 192;
        if (kind == 0) {
            const int b = v / 96, h = (v / 16) % 6, qb = v & 15; const size_t row0 = MCTX + (size_t)b * 4096 + qb * 256, kv0 = MCTX + (size_t)b * 4352;
            attn_unit<96>(QM + row0 * 768 + h * 96, 768, KVM + kv0 * 768 + h * 128, 768, KROPE + kv0 * 32, KVM + kv0 * 768 + h * 128 + 64, 768, 4352, CAT + row0 * 1024 + 640 + h * 64, lds, (const float*)(a->ws + WS_ROPE32), qb * 256);
        } else if (kind == 1) {
            const int b = v / 96, kvh = (v / 48) & 1, g = (v / 16) % 3, qb = v & 15, hq = kvh * 3 + g; const size_t row0 = MCTX + (size_t)b * 4096 + qb * 256, kv0 = MCTX + (size_t)b * 4352;
            attn_unit<64>(QG + row0 * 384 + hq * 64, 384, KG + kv0 * 128 + kvh * 64, 128, nullptr, VG + kv0 * 128 + kvh * 64, 128, 4352, CAT + row0 * 1024 + hq * 64, lds, nullptr, 0);
        } else if (kind == 2) {
            const int b = v / 6, h = v % 6; const size_t row0 = (size_t)b * 256;
            attn_unit<96>(QM + row0 * 768 + h * 96, 768, KVM + row0 * 768 + h * 128, 768, KROPE + row0 * 32, KVM + row0 * 768 + h * 128 + 64, 768, 256, CAT + row0 * 1024 + 640 + h * 64, lds, nullptr, 0);
        } else {
            const int b = v / 6, hq = v % 6, kvh = hq / 3; const size_t row0 = (size_t)b * 256;
            attn_unit<64>(QG + row0 * 384 + hq * 64, 384, KG + row0 * 128 + kvh * 64, 128, nullptr, VG + row0 * 128 + kvh * 64, 128, 256, CAT + row0 * 1024 + hq * 64, lds, nullptr, 0);
        }
    }
}

#define XB_TMO      128
#define XB_XCNT(j)  (256  + 64 * (j))
#define XB_XSUB(j)  (1280 + 64 * (j))
#define XB_XGEN(j)  (2304 + 64 * (j))
#define XB_TOP      3328
#define XB_TOPGEN   3392
#define XCD_BAR_WORDS 3456
#define XB_SPIN_CAP (1u << 18)

__device__ __forceinline__ unsigned xb_ld(unsigned* p)              { return __hip_atomic_load(p, __ATOMIC_RELAXED, __HIP_MEMORY_SCOPE_AGENT); }
__device__ __forceinline__ unsigned xb_add(unsigned* p, unsigned v) { return __hip_atomic_fetch_add(p, v, __ATOMIC_RELAXED, __HIP_MEMORY_SCOPE_AGENT); }
__device__ __forceinline__ unsigned xb_xcc_id() { return (unsigned)__builtin_amdgcn_s_getreg((3 << 11) | 20) & 0xFu; }
#define XB_SPIN(cond, bar) do { unsigned _sp = 0; while (cond) { __builtin_amdgcn_s_sleep(1); \
    if ((++_sp & 255u) == 0u) { if (xb_ld(&(bar)[XB_TMO])) break; if (_sp > XB_SPIN_CAP) { atomicAdd(&(bar)[XB_TMO], 1u); break; } } } } while (0)

struct XcdBarrier {
    unsigned* bar; unsigned x;
    volatile LAS unsigned* st;
};

__device__ __forceinline__ XcdBarrier xcd_barrier_post(unsigned* bar, volatile LAS unsigned* st) {
    XcdBarrier b; b.bar = bar; b.x = xb_xcc_id(); b.st = st;
    if (threadIdx.x == 0) (void)xb_add(&bar[XB_XCNT(b.x)], 1u);
    return b;
}
__device__ __forceinline__ void xcd_barrier_complete(unsigned* bar, unsigned x, unsigned& nloc, unsigned& nx) {
    const unsigned G = gridDim.x * gridDim.y * gridDim.z;
    unsigned sum, cnt, mine, sp = 0u;
    for (;;) {
        sum = 0u; cnt = 0u; mine = 0u;
#pragma unroll
        for (unsigned j = 0; j < 16; ++j) { const unsigned c = xb_ld(&bar[XB_XCNT(j)]); sum += c; cnt += (c > 0u) ? 1u : 0u; mine = (j == x) ? c : mine; }
        if (sum == G) break;
        __builtin_amdgcn_s_sleep(1);
        if ((++sp & 255u) == 0u) { if (xb_ld(&bar[XB_TMO])) break; if (sp > XB_SPIN_CAP) { atomicAdd(&bar[XB_TMO], 1u); break; } }
    }
    nloc = mine > 0u ? mine : 1u; nx = cnt > 0u ? cnt : 1u;
}

__device__ __forceinline__ void xcd_barrier(const XcdBarrier& b) {
    asm volatile("s_waitcnt vmcnt(0)" ::: "memory");
    __syncthreads();
    if (threadIdx.x == 0) {
        unsigned* bar = b.bar;
        __builtin_amdgcn_s_waitcnt(0);
        unsigned nloc = b.st[0], nx = b.st[1];
        if (nloc == 0u) { xcd_barrier_complete(bar, b.x, nloc, nx); b.st[0] = nloc; b.st[1] = nx; }
        const unsigned old = xb_add(&bar[XB_XSUB(b.x)], 1u);
        const unsigned gen = old / nloc;
        if (old + 1u == (gen + 1u) * nloc) {
            __builtin_amdgcn_fence(__ATOMIC_RELEASE, "agent");
            asm volatile("s_waitcnt vmcnt(0)" ::: "memory");
            const unsigned og = xb_add(&bar[XB_TOP], 1u);
            const unsigned tg = og / nx;
            if (og + 1u == (tg + 1u) * nx) xb_add(&bar[XB_TOPGEN], 1u);
            else XB_SPIN(xb_ld(&bar[XB_TOPGEN]) == tg, bar);
            __builtin_amdgcn_fence(__ATOMIC_ACQUIRE, "agent");
            xb_add(&bar[XB_XGEN(b.x)], 1u);
            asm volatile("s_waitcnt vmcnt(0)" ::: "memory");
        } else {
            XB_SPIN(xb_ld(&bar[XB_XGEN(b.x)]) == gen, bar);
            __builtin_amdgcn_fence(__ATOMIC_ACQUIRE, "agent");
            asm volatile("s_waitcnt vmcnt(0)" ::: "memory");
        }
    }
    __syncthreads();
}

__global__ void __launch_bounds__(NTHREADS, 2) mk_fwd(Args a_in) {
    extern __shared__ __attribute__((aligned(16))) unsigned char lds_raw[];
    LAS unsigned char* lds = (LAS unsigned char*)lds_raw;
    cg::grid_group grid = cg::this_grid();
    const int G = gridDim.x;
    volatile LAS unsigned* MISC = (volatile LAS unsigned*)(lds + 8 * 17408);
    if (threadIdx.x < 16) MISC[threadIdx.x] = 0u;
    __syncthreads();
    XcdBarrier bar = xcd_barrier_post((unsigned*)(a_in.ws + WS_CTL), MISC + 8);
    for (int ph = a_in.ph_lo; ph < a_in.ph_hi; ++ph) {
        ArgsP a = (ArgsP)__builtin_amdgcn_kernarg_segment_ptr(); asm volatile("" : "+s"(a));
        unsigned char* ws = a->ws;
        int bx = blockIdx.x; asm volatile("" : "+s"(bx));
        const int spid = (ph == 0) ? 12 : (ph == 49) ? 14 : (ph - 1) % 12;
        const int nrep = ((DUPM >> spid) & 1) ? 2 : 1;
#pragma unroll 1
        for (int rep = 0; rep < nrep; ++rep) {
        if (ph == 0) { if (PHM & 1) phase_prologue(a, lds); }
        else if (ph == 49) { if (PHM & 2) phase_final_norm(a); }
        else {
            const int l = (ph - 1) / 12, sp = (ph - 1) % 12;
            const float* mods = (const float*)(ws + WS_MODS) + (size_t)l * 3 * 9216;
            if (sp == 0 || sp == 3 || sp == 9) { if (PHM & 2) phase_norm(a, l, sp == 0 ? 0 : sp == 3 ? 1 : 2); }
            else if ((PHM & 4) && (sp == 1 || sp == 10)) {
                const int j = sp == 1 ? 0 : 1;
                pg8::Gemm g{(const bf16_t*)(ws + WS_XN), (const bf16_t*)(ws + WS_WGU + (size_t)(l * 2 + j) * SZ_WGU1), M, NGU, DM};
                pg8::StaticOrder S; S.init(M, NGU, G, bx);
                pg8::EpiSwiGLU E{(bf16_t*)(ws + WS_R1)};
                pg8::gemm_phase<pg8::EpiSwiGLU, pg8::StaticOrder, true, true>(lds, g, S, E);
            } else if ((PHM & 8) && (sp == 2 || sp == 11)) {
                const int j = sp == 2 ? 0 : 1;
                pg8::Gemm g{(const bf16_t*)(ws + WS_R1), (const bf16_t*)(ws + WS_WD + (size_t)(l * 2 + j) * SZ_WD1), M, DM, FF};
                pg8::StaticOrder S; S.init(M, DM, G, bx);
                pg8::EpiResid E{(const float*)(ws + WS_X), (float*)(ws + WS_X), mods + (j == 0 ? 2 : 8) * 1024, (nrep == 2 && rep == 0) ? 0.0f : 0.5f};
                pg8::gemm_phase<pg8::EpiResid, pg8::StaticOrder, true, true>(lds, g, S, E);
            } else if ((PHM & 16) && sp == 4) {
                pg8::Gemm g{(const bf16_t*)(ws + WS_XN), (const bf16_t*)(ws + WS_WIN + (size_t)l * SZ_WIN1), M, NIN, DM};
                pg8::StaticOrder S; S.init(M, NIN, G, bx);
                pg8::EpiF32 E{(float*)(ws + WS_PROJ), NIN};
                pg8::gemm_phase<pg8::EpiF32, pg8::StaticOrder, true, true>(lds, g, S, E);
            } else if (sp == 5) { if (PHM & 32) phase_prep(a, l); }
            else if (sp == 6) {
                int k256 = 256; asm volatile("" : "+s"(k256));
                if (PHM & 64) {
                    pg8::Gemm g{(const bf16_t*)(ws + WS_R1 + R1_QLATN), (const bf16_t*)(ws + WS_WUQ + (size_t)l * SZ_WUQ1), M, 768, k256};
                    pg8::StaticOrder S; S.init(M, 768, G, bx);
                    pg8::EpiBf16S E{(bf16_t*)(ws + WS_R1 + R1_QM), 768, 0.10206207261596575f * LOG2E};
                    pg8::gemm_phase<pg8::EpiBf16S, pg8::StaticOrder, true, true>(lds, g, S, E);
                }
                if (PHM & 128) {
                    pg8::Gemm g{(const bf16_t*)(ws + WS_R1 + R1_CKV), (const bf16_t*)(ws + WS_WUKV + (size_t)l * SZ_WUKV1), KVROWS, 768, k256};
                    pg8::StaticOrder S; S.init(KVROWS, 768, G, bx);
                    pg8::EpiBf16S E{(bf16_t*)(ws + WS_R1 + R1_KVM), 768, 1.0f};
                    pg8::gemm_phase<pg8::EpiBf16S, pg8::StaticOrder, true, true>(lds, g, S, E);
                }
                if ((PHM & 256) && rep == 0) phase_mlstm_scan(a, l);
            } else if (sp == 7) { if ((PHM & 512) && (rep == 0 || !(DUPM & 8192))) phase_mlstm_out(a, l); if ((PHM & 1024) && (rep == 0 || (DUPM & 8192))) phase_attention(a, lds); }
            else if ((PHM & 2048) && sp == 8) {
                pg8::Gemm g{(const bf16_t*)(ws + WS_XN), (const bf16_t*)(ws + WS_WOUT + (size_t)l * SZ_WOUT1), M, DM, DM};
                pg8::StaticOrder S; S.init(M, DM, G, bx);
                pg8::EpiResid E{(const float*)(ws + WS_X), (float*)(ws + WS_X), mods + 5 * 1024, (nrep == 2 && rep == 0) ? 0.0f : 1.0f};
                pg8::gemm_phase<pg8::EpiResid, pg8::StaticOrder, true, true>(lds, g, S, E);
            }
        }
        }
        if (ph + 1 < a_in.ph_hi) { if (ph == a_in.ph_lo) grid.sync(); else xcd_barrier(bar); }
#if defined(MK_XSYNC)
        for (int xs = 0; xs < MK_XSYNC; ++xs) xcd_barrier(bar);
#endif
    }
}

extern "C" void kernel_launch(void* const* d_in, const int* in_sizes, int n_in, void* d_out, int out_size, void* d_ws, size_t ws_size, hipStream_t stream) {
    static int grid = 0;
    if (grid == 0) {
        if (n_in != 28 || ws_size < WS_END) { fprintf(stderr, "kernel_launch: unexpected n_in %d or ws_size %zu (< %zu)\n", n_in, ws_size, (size_t)WS_END); grid = -1; return; }
        int dev = 0, cus = 0, per_cu = 0;
        hipGetDevice(&dev); hipDeviceGetAttribute(&cus, hipDeviceAttributeMultiprocessorCount, dev);
        hipFuncSetAttribute((const void*)mk_fwd, hipFuncAttributeMaxDynamicSharedMemorySize, LDS_BYTES);
        hipOccupancyMaxActiveBlocksPerMultiprocessor(&per_cu, (const void*)mk_fwd, NTHREADS, LDS_BYTES);
        (void)hipGetLastError();
        if (per_cu < 1) per_cu = 1;
        grid = cus;
        if (grid <= 0) grid = 256;
    }
    if (grid < 0) return;
    Args a{};
    for (int i = 0; i < 28; ++i) a.in[i] = (const float*)d_in[i];
    a.out = (float*)d_out; a.ws = (unsigned char*)d_ws;
    if (hipMemsetAsync((unsigned char*)d_ws + WS_CTL, 0, CTL_BYTES, stream) != hipSuccess) { fprintf(stderr, "kernel_launch: memset of the barrier words failed\n"); return; }
#if MK_MULTI_LAUNCH
    for (int ph = 0; ph < 50; ++ph) { a.ph_lo = ph; a.ph_hi = ph + 1; hipLaunchKernelGGL(mk_fwd, dim3(grid), dim3(NTHREADS), LDS_BYTES, stream, a); }
#else
    a.ph_lo = 0; a.ph_hi = 50;
    void* args[] = {&a};
    hipError_t e = hipLaunchCooperativeKernel((const void*)mk_fwd, dim3(grid), dim3(NTHREADS), args, LDS_BYTES, stream);
    if (e != hipSuccess) fprintf(stderr, "cooperative launch failed: %s (grid %d)\n", hipGetErrorString(e), grid);
#endif
}
```
